# Optimizing an MI355X kernel written in HIP

```python
import math
import jax, jax.numpy as jnp
from jax import lax
import numpy as np

D_MODEL = 1024
BATCH = 4
SEQ = 4096
DEPTH = 4

GRID_W = 64
CTX_LEN = 256
EPS = 1e-6

ATT_HEADS = 8
ATT_KV_HEADS = 2
ATT_HEAD_DIM = 64
ATT_WINDOW = 128
ATT_BLOCK = 128
ROPE_THETA = 10000.0
ML_HEADS = 4
ML_HEAD_DIM = 128
ML_CHUNK = 128
HY_WIDTH = 512
HY_ORDER = 2
HY_EMB_BANDS = 16
HY_EMB_DIM = 1 + 2 * HY_EMB_BANDS
HY_FILTER_WIDTH = 64
HY_SHORT = 3
HY_DECAY_TARGET = 1e-2
HY_DECAY_FAST = 0.3
HY_DECAY_SLOW = 1.5
D_FF = 2816
FFN_CONV = 3

ATT_Q = ATT_HEADS * ATT_HEAD_DIM
ATT_KV = ATT_KV_HEADS * ATT_HEAD_DIM
ML_W = ML_HEADS * ML_HEAD_DIM
ML_GATES = 2 * 2 * ML_HEADS
N_BRANCH = 3
BRANCH_W = 512
IN_SIZES = (ATT_Q, ATT_KV, ATT_KV, ML_W, ML_W, ML_W, ML_W, ML_GATES, 3 * HY_WIDTH, N_BRANCH * D_MODEL)
IN_WIDTH = sum(IN_SIZES)
IN_OFFSETS = tuple(int(o) for o in np.cumsum(IN_SIZES)[:-1])

kernel_name = 'hybrid_attn_mlstm_hyena_dit'

F32 = jnp.float32


def rms_norm(x, g):
    xf = x.astype(F32)
    y = xf * lax.rsqrt(jnp.mean(xf * xf, axis=-1, keepdims=True) + EPS)
    return (y * g.astype(F32)).astype(x.dtype)


def dwconv_centered(x, w, b):
    K = w.shape[0]
    pad = K // 2
    L = x.shape[1]
    xp = jnp.pad(x, ((0, 0), (pad, pad), (0, 0)))
    out = b + xp[:, 0:L] * w[0]
    for j in range(1, K):
        out = out + xp[:, j:j + L] * w[j]
    return out


def split_heads(t, n):
    return t.reshape(*t.shape[:-1], n, -1)


def axial_rope_angles(L):
    rows = L // GRID_W
    row = jnp.repeat(jnp.arange(rows, dtype=F32), GRID_W)
    col = jnp.tile(jnp.arange(GRID_W, dtype=F32), rows)
    nf = ATT_HEAD_DIM // 4
    inv = ROPE_THETA ** (-jnp.arange(nf, dtype=F32) / nf)
    ang = jnp.concatenate([row[:, None] * inv, col[:, None] * inv], axis=-1)
    return jnp.cos(ang), jnp.sin(ang)


def apply_rope(t, cos, sin):
    half = t.shape[-1] // 2
    t1 = t[..., :half].astype(F32)
    t2 = t[..., half:].astype(F32)
    c = cos[:, None, :]
    s = sin[:, None, :]
    return jnp.concatenate([t1 * c - t2 * s, t2 * c + t1 * s], axis=-1).astype(t.dtype)


def window_attention(q, k, v, kc, vc, sink):
    B, L, Hq, hd = q.shape
    Hkv = k.shape[2]
    G = Hq // Hkv
    T = ATT_BLOCK
    nb = L // T
    Lc = kc.shape[1]
    scale = hd ** -0.5
    qb = q.reshape(B, nb, T, Hkv, G, hd)

    def band(t):
        tp = jnp.pad(t, ((0, 0), (T, T), (0, 0), (0, 0))).reshape(B, nb + 2, T, Hkv, hd)
        return jnp.concatenate([tp[:, :-2], tp[:, 1:-1], tp[:, 2:]], axis=2)

    kb, vb = band(k), band(v)
    blk = jnp.arange(nb)[:, None, None]
    qpos = blk * T + jnp.arange(T)[None, :, None]
    kpos = (blk - 1) * T + jnp.arange(3 * T)[None, None, :]
    valid = (jnp.abs(kpos - qpos) <= ATT_WINDOW) & (kpos >= 0) & (kpos < L)
    s_loc = jnp.einsum('bntkgd,bnskd->bnkgts', qb, kb).astype(F32) * scale
    s_loc = jnp.where(valid[None, :, None, None], s_loc, -jnp.inf)
    s_ctx = jnp.einsum('bntkgd,bckd->bnkgtc', qb, kc).astype(F32) * scale
    s_sink = jnp.broadcast_to(sink.astype(F32).reshape(Hkv, G, 1, 1), s_ctx.shape[:-1] + (1,))
    p = jax.nn.softmax(jnp.concatenate([s_sink, s_ctx, s_loc], axis=-1), axis=-1)
    p_ctx = p[..., 1:1 + Lc].astype(v.dtype)
    p_loc = p[..., 1 + Lc:].astype(v.dtype)
    o = jnp.einsum('bnkgts,bnskd->bntkgd', p_loc, vb) + jnp.einsum('bnkgtc,bckd->bntkgd', p_ctx, vc)
    return o.reshape(B, L, Hq * hd).astype(v.dtype)


def context_attention(q, k, v, sink):
    B, Lc, Hq, hd = q.shape
    Hkv = k.shape[2]
    G = Hq // Hkv
    qg = q.reshape(B, Lc, Hkv, G, hd)
    s = jnp.einsum('btkgd,bskd->bkgts', qg, k).astype(F32) * hd ** -0.5
    s_sink = jnp.broadcast_to(sink.astype(F32).reshape(Hkv, G, 1, 1), s.shape[:-1] + (1,))
    p = jax.nn.softmax(jnp.concatenate([s_sink, s], axis=-1), axis=-1)[..., 1:].astype(v.dtype)
    o = jnp.einsum('bkgts,bskd->btkgd', p, v)
    return o.reshape(B, Lc, Hq * hd).astype(v.dtype)


def mlstm_scan(q, k, v, i_pre, logf, state):
    B, H, L, d = q.shape
    T = ML_CHUNK
    nc = L // T

    def chunks(a):
        return jnp.moveaxis(a.reshape(B, H, nc, T, *a.shape[3:]), 2, 0)

    tril = jnp.tril(jnp.ones((T, T), dtype=bool))

    def step(carry, inp):
        C, n, m = carry
        qc, kc, vc, ic, fc = inp
        b = jnp.cumsum(fc, axis=-1)
        a = b + m[..., None]
        dmat = jnp.where(tril, b[..., :, None] - b[..., None, :] + ic[..., None, :], -jnp.inf)
        mt = jnp.maximum(a, jnp.max(dmat, axis=-1))
        w_inter = jnp.exp(a - mt)
        s = jnp.einsum('bhtd,bhsd->bhts', qc, kc) * jnp.exp(dmat - mt[..., None])
        num = w_inter[..., None] * jnp.einsum('bhvk,bhtk->bhtv', C, qc) + jnp.einsum('bhts,bhsv->bhtv', s, vc)
        den = w_inter * jnp.einsum('bhk,bhtk->bht', n, qc) + jnp.sum(s, axis=-1)
        h = num / jnp.maximum(jnp.abs(den), jnp.exp(-mt))[..., None]
        bl = b[..., -1]
        src = bl[..., None] - b + ic
        m_new = jnp.maximum(bl + m, jnp.max(src, axis=-1))
        g = jnp.exp(src - m_new[..., None])
        decay = jnp.exp(bl + m - m_new)
        C_new = decay[..., None, None] * C + jnp.einsum('bhs,bhsv,bhsk->bhvk', g, vc, kc)
        n_new = decay[..., None] * n + jnp.einsum('bhs,bhsk->bhk', g, kc)
        return (C_new, n_new, m_new), h

    state, hs = lax.scan(step, state, (chunks(q), chunks(k), chunks(v), chunks(i_pre), chunks(logf)))
    return jnp.moveaxis(hs, 0, 2).reshape(B, H, L, d), state


def mlstm_inputs(p, gate_b):
    B, L, _ = p[3].shape

    def to_bhld(t):
        return split_heads(t, ML_HEADS).astype(F32).transpose(0, 2, 1, 3)

    q = to_bhld(p[3])
    k = to_bhld(p[4]) * ML_HEAD_DIM ** -0.5
    v = to_bhld(p[5])
    g = p[7].astype(F32).reshape(B, L, 2, 2, ML_HEADS) + gate_b.astype(F32)
    g = jnp.moveaxis(g, 1, -1)
    return q, k, v, g[:, :, 0], jax.nn.log_sigmoid(g[:, :, 1])


def mlstm_bidir(ctx_in, lat_in, need_ctx):
    qc, kc, vc, ic, fc = ctx_in
    ql, kl, vl, il, fl = lat_in
    B, H, _, d = ql.shape
    zero = (jnp.zeros((B, H, d, d), F32), jnp.zeros((B, H, d), F32), jnp.zeros((B, H), F32))

    def flip(t):
        return jnp.flip(t, axis=2)

    hcf, sf = mlstm_scan(qc, kc, vc, ic[:, 0], fc[:, 0], zero)
    hlf, _ = mlstm_scan(ql, kl, vl, il[:, 0], fl[:, 0], sf)
    hcb, sb = mlstm_scan(flip(qc), flip(kc), flip(vc), flip(ic[:, 1]), flip(fc[:, 1]), zero)
    hlb, _ = mlstm_scan(flip(ql), flip(kl), flip(vl), flip(il[:, 1]), flip(fl[:, 1]), sb)
    h_lat = hlf + flip(hlb)
    h_ctx = hcf + flip(hcb) if need_ctx else None
    return h_lat, h_ctx


def mlstm_output(h, o_pre, g):
    B, H, L, d = h.shape
    h = h.transpose(0, 2, 1, 3)
    y = h * lax.rsqrt(jnp.mean(h * h, axis=-1, keepdims=True) + EPS) * g.astype(F32).reshape(H, d)
    y = y * jax.nn.sigmoid(split_heads(o_pre, ML_HEADS).astype(F32))
    return y.reshape(B, L, H * d).astype(o_pre.dtype)


def hyena_filters(L, w1, b1, w2, b2, w3, freq):
    t = jnp.arange(L, dtype=F32)
    t_norm = t / max(L - 1, 1)
    w = 2.0 * math.pi * t / L
    bands = jnp.linspace(1e-4, HY_EMB_BANDS - 1, HY_EMB_BANDS, dtype=F32)
    z = jnp.concatenate([t_norm[:, None], jnp.cos(w[:, None] * bands), -jnp.sin(w[:, None] * bands)], axis=-1)
    z = z.astype(w1.dtype)
    h = jnp.sin(freq[0] * (z @ w1 + b1))
    h = jnp.sin(freq[1] * (h @ w2 + b2))
    h = (h @ w3).astype(F32).reshape(L, HY_ORDER, 2, HY_WIDTH)
    deltas = jnp.abs(jnp.linspace(math.log(HY_DECAY_TARGET) / HY_DECAY_SLOW,
                                  math.log(HY_DECAY_TARGET) / HY_DECAY_FAST, HY_WIDTH, dtype=F32))
    h = h * jnp.exp(-t_norm[:, None] * deltas)[:, None, None, :]
    return h / jnp.sum(jnp.abs(h), axis=0, keepdims=True)


def bidir_long_conv(u, hf, hb, skip):
    L = u.shape[1]
    n = 2 * L
    U = jnp.fft.rfft(u.astype(F32), n=n, axis=1)
    Hf = jnp.fft.rfft(hf, n=n, axis=0) + jnp.conj(jnp.fft.rfft(hb, n=n, axis=0))
    y = jnp.fft.irfft(U * Hf[None], n=n, axis=1)[:, :L]
    return (y + u.astype(F32) * skip.astype(F32)).astype(u.dtype)


def hyena_operator(u, filt, skip):
    x1, x2, v = jnp.split(u, 3, axis=-1)
    z = v
    for o, gate in enumerate((x1, x2)):
        z = gate * bidir_long_conv(z, filt[:, o, 0], filt[:, o, 1], skip[o])
    return z


def merge_branches(branches, gate_pre, w_branch, w_out):
    gates = jax.nn.sigmoid(gate_pre).reshape(*gate_pre.shape[:-1], N_BRANCH, -1)
    y = gates[..., 0, :] * (branches[0] @ w_branch[0])
    for r in range(1, N_BRANCH):
        y = y + gates[..., r, :] * (branches[r] @ w_branch[r])
    return y @ w_out


def token_mixers(hl, hc, cos, sin, w_in, sink, gate_b, ml_g, hy_sw, hy_sb, hy_fp, hy_skip, w_branch, w_out, need_ctx):
    L = hl.shape[1]
    Lc = hc.shape[1]
    pl = jnp.split(hl @ w_in, IN_OFFSETS, axis=-1)
    pc = jnp.split(hc @ w_in, IN_OFFSETS, axis=-1)
    ql = apply_rope(split_heads(pl[0], ATT_HEADS), cos, sin)
    kl = apply_rope(split_heads(pl[1], ATT_KV_HEADS), cos, sin)
    vl = split_heads(pl[2], ATT_KV_HEADS)
    kc = split_heads(pc[1], ATT_KV_HEADS)
    vc = split_heads(pc[2], ATT_KV_HEADS)
    att_l = window_attention(ql, kl, vl, kc, vc, sink)
    h_lat, h_ctx = mlstm_bidir(mlstm_inputs(pc, gate_b), mlstm_inputs(pl, gate_b), need_ctx)
    mls_l = mlstm_output(h_lat, pl[6], ml_g)
    hy_l = hyena_operator(dwconv_centered(pl[8], hy_sw, hy_sb), hyena_filters(L, *hy_fp), hy_skip)
    y_l = merge_branches((att_l, mls_l, hy_l), pl[9], w_branch, w_out)
    if not need_ctx:
        return y_l, None
    att_c = context_attention(split_heads(pc[0], ATT_HEADS), kc, vc, sink)
    mls_c = mlstm_output(h_ctx, pc[6], ml_g)
    hy_c = hyena_operator(dwconv_centered(pc[8], hy_sw, hy_sb), hyena_filters(Lc, *hy_fp), hy_skip)
    y_c = merge_branches((att_c, mls_c, hy_c), pc[9], w_branch, w_out)
    return y_l, y_c


def conv_ffn(h, w_up, cw, cb, w_down):
    u = dwconv_centered(h @ w_up, cw, cb)
    gate, val = jnp.split(u, 2, axis=-1)
    return (jax.nn.silu(gate) * val) @ w_down


def setup_inputs(seed: int = 0) -> dict:
    key = jax.random.key(seed)
    kit = iter(jax.random.split(key, 40))
    D = D_MODEL

    def nrm(shape, scale):
        return jax.random.normal(next(kit), shape, F32) * scale

    i_b = nrm((DEPTH, 2, ML_HEADS), 0.1)
    f_b = jnp.linspace(3.0, 6.0, ML_HEADS, dtype=F32) + nrm((DEPTH, 2, ML_HEADS), 0.1)
    return {
        'x': nrm((BATCH, SEQ, D), 1.0),
        'c': nrm((BATCH, D), 1.0),
        'ctx': nrm((BATCH, CTX_LEN, D), 1.0),
        'c_ctx': nrm((D,), 1.0),
        'ada_w': nrm((DEPTH, D, 6 * D), 0.5 * D ** -0.5),
        'ada_b': nrm((DEPTH, 6 * D), 0.02),
        'norm1_g': 1.0 + nrm((DEPTH, D), 0.05),
        'norm2_g': 1.0 + nrm((DEPTH, D), 0.05),
        'w_in': nrm((DEPTH, D, IN_WIDTH), D ** -0.5),
        'att_sink': nrm((DEPTH, ATT_HEADS), 0.5),
        'ml_gate_b': jnp.stack([i_b, f_b], axis=2),
        'ml_norm_g': 1.0 + nrm((DEPTH, ML_W), 0.05),
        'hy_short_w': nrm((DEPTH, HY_SHORT, 3 * HY_WIDTH), HY_SHORT ** -0.5),
        'hy_short_b': nrm((DEPTH, 3 * HY_WIDTH), 0.02),
        'hy_w1': nrm((DEPTH, HY_EMB_DIM, HY_FILTER_WIDTH), HY_EMB_DIM ** -0.5),
        'hy_b1': nrm((DEPTH, HY_FILTER_WIDTH), 0.02),
        'hy_w2': nrm((DEPTH, HY_FILTER_WIDTH, HY_FILTER_WIDTH), HY_FILTER_WIDTH ** -0.5),
        'hy_b2': nrm((DEPTH, HY_FILTER_WIDTH), 0.02),
        'hy_w3': nrm((DEPTH, HY_FILTER_WIDTH, HY_ORDER * 2 * HY_WIDTH), HY_FILTER_WIDTH ** -0.5),
        'hy_freq': 1.0 + nrm((DEPTH, 2, HY_FILTER_WIDTH), 0.1),
        'hy_skip': nrm((DEPTH, HY_ORDER, HY_WIDTH), 0.5),
        'w_branch': nrm((DEPTH, N_BRANCH, BRANCH_W, D), BRANCH_W ** -0.5),
        'w_out': nrm((DEPTH, D, D), D ** -0.5),
        'w_up': nrm((DEPTH, D, 2 * D_FF), D ** -0.5),
        'ffn_conv_w': nrm((DEPTH, FFN_CONV, 2 * D_FF), FFN_CONV ** -0.5),
        'ffn_conv_b': nrm((DEPTH, 2 * D_FF), 0.02),
        'w_down': nrm((DEPTH, D_FF, D), D_FF ** -0.5),
        'final_g': 1.0 + nrm((D,), 0.05),
    }


def reference(x, c, ctx, c_ctx, ada_w, ada_b, norm1_g, norm2_g, w_in, att_sink, ml_gate_b, ml_norm_g,
              hy_short_w, hy_short_b, hy_w1, hy_b1, hy_w2, hy_b2, hy_w3, hy_freq, hy_skip,
              w_branch, w_out, w_up, ffn_conv_w, ffn_conv_b, w_down, final_g):
    L = x.shape[1]
    cos, sin = axial_rope_angles(L)
    sc = jax.nn.silu(c)
    scc = jax.nn.silu(c_ctx)
    xl, xc = x, ctx
    for l in range(DEPTH):
        need_ctx = l < DEPTH - 1
        sh1, sc1, g1, sh2, sc2, g2 = [m[:, None, :] for m in jnp.split(sc @ ada_w[l] + ada_b[l], 6, axis=-1)]
        csh1, csc1, cg1, csh2, csc2, cg2 = jnp.split(scc @ ada_w[l] + ada_b[l], 6, axis=-1)
        hl = rms_norm(xl, norm1_g[l]) * (1.0 + sc1) + sh1
        hc = rms_norm(xc, norm1_g[l]) * (1.0 + csc1) + csh1
        hy_fp = (hy_w1[l], hy_b1[l], hy_w2[l], hy_b2[l], hy_w3[l], hy_freq[l])
        yl, yc = token_mixers(hl, hc, cos, sin, w_in[l], att_sink[l], ml_gate_b[l], ml_norm_g[l],
                              hy_short_w[l], hy_short_b[l], hy_fp, hy_skip[l], w_branch[l], w_out[l], need_ctx)
        xl = xl + g1 * yl
        hl = rms_norm(xl, norm2_g[l]) * (1.0 + sc2) + sh2
        xl = xl + g2 * conv_ffn(hl, w_up[l], ffn_conv_w[l], ffn_conv_b[l], w_down[l])
        if need_ctx:
            xc = xc + cg1 * yc
            hc = rms_norm(xc, norm2_g[l]) * (1.0 + csc2) + csh2
            xc = xc + cg2 * conv_ffn(hc, w_up[l], ffn_conv_w[l], ffn_conv_b[l], w_down[l])
    return rms_norm(xl, final_g)
```

```cpp
#include <hip/hip_runtime.h>
#include <hip/hip_cooperative_groups.h>
#include <cstdio>
namespace cg = cooperative_groups;

#define DEV __device__ __forceinline__
typedef unsigned short bf16_t;
typedef short bf16x8 __attribute__((ext_vector_type(8)));
typedef float f32x4 __attribute__((ext_vector_type(4)));

constexpr int D = 1024, L = 4096, LC = 256, M_LAT = 16384, M_CTX = 1024, M_ALL = 17408;
constexpr int N_IN = 7440, N_INP = 4480, DFF = 2816;
constexpr int NTH = 256;
constexpr int SMEM_BYTES = 77824;
constexpr float EPS = 1e-6f;

constexpr size_t al256(size_t x) { return (x + 255) & ~(size_t)255; }
constexpr size_t OFF_X = 0;
constexpr size_t OFF_A = OFF_X + al256((size_t)M_ALL * D * 4);
constexpr size_t OFF_MOD = OFF_A + al256((size_t)M_ALL * D * 2);
constexpr size_t OFF_TW = OFF_MOD + al256((size_t)4 * 5 * 6144 * 4);
constexpr size_t OFF_ROPE = OFF_TW + al256((size_t)4096 * 8);
constexpr size_t OFF_HID = OFF_ROPE + al256((size_t)4096 * 64 * 4);
constexpr size_t OFF_WIN = OFF_HID + al256((size_t)4 * 4352 * 64 * 4);
constexpr size_t OFF_WG = OFF_WIN + al256((size_t)N_INP * 1024 * 2);
constexpr size_t OFF_WBR = OFF_WG + al256((size_t)3072 * 1024 * 2);
constexpr size_t OFF_WOUT = OFF_WBR + al256((size_t)3 * 1024 * 512 * 2);
constexpr size_t OFF_WUP = OFF_WOUT + al256((size_t)1024 * 1024 * 2);
constexpr size_t OFF_WDN = OFF_WUP + al256((size_t)5632 * 1024 * 2);
constexpr size_t OFF_FILT = OFF_WDN + al256((size_t)1024 * 2816 * 2);
constexpr size_t OFF_FILTC = OFF_FILT + al256((size_t)2048 * 4096 * 4);
constexpr size_t OFF_STATS = OFF_FILTC + al256((size_t)2048 * 256 * 4);
constexpr size_t OFF_BIG = OFF_STATS + al256((size_t)32 * 34 * 4 * 4);
constexpr size_t OFF_QKV = OFF_BIG;
constexpr size_t OFF_ML = OFF_QKV + al256((size_t)M_ALL * 768 * 2);
constexpr size_t OFF_MLG = OFF_ML + al256((size_t)M_ALL * 2048 * 2);
constexpr size_t OFF_HYT = OFF_MLG + al256((size_t)M_ALL * 16 * 4);
constexpr size_t OFF_HYTC = OFF_HYT + al256((size_t)M_LAT * 1536 * 2);
constexpr size_t OFF_ATT = OFF_HYTC + al256((size_t)M_CTX * 1536 * 2);
constexpr size_t OFF_MLS = OFF_ATT + al256((size_t)M_ALL * 512 * 2);
constexpr size_t OFF_HYO = OFF_MLS + al256((size_t)M_ALL * 512 * 2);
constexpr size_t OFF_STATES = OFF_HYO + al256((size_t)M_ALL * 512 * 2);
constexpr size_t OFF_Y = OFF_STATES;
constexpr size_t END_MIX = OFF_STATES + al256((size_t)32 * 34 * 16512 * 4);
constexpr size_t OFF_U = OFF_BIG;
constexpr size_t OFF_G = OFF_U + al256((size_t)M_ALL * 5632 * 2);
constexpr size_t END_FFN = OFF_G + al256((size_t)M_ALL * 2816 * 2);
constexpr size_t WS_NEED = END_MIX > END_FFN ? END_MIX : END_FFN;

struct Params {
  const float *x, *c, *ctx, *c_ctx, *ada_w, *ada_b, *norm1_g, *norm2_g, *w_in, *att_sink, *ml_gate_b, *ml_norm_g,
      *hy_short_w, *hy_short_b, *hy_w1, *hy_b1, *hy_w2, *hy_b2, *hy_w3, *hy_freq, *hy_skip, *w_branch, *w_out, *w_up,
      *ffn_conv_w, *ffn_conv_b, *w_down, *final_g;
  float* out;
  char* ws;
};

typedef const __attribute__((address_space(4))) Params* KP;
DEV KP lp(KP q) { asm volatile("" : "+s"(q)); return q; }
DEV int otid() { int t = threadIdx.x; asm volatile("" : "+v"(t)); return t; }
DEV bf16_t f2bf(float f) { unsigned u = __float_as_uint(f); u += 0x7fffu + ((u >> 16) & 1u); return (bf16_t)(u >> 16); }
DEV float bf2f(bf16_t h) { return __uint_as_float(((unsigned)h) << 16); }
DEV unsigned pack2(float a, float b) { return (unsigned)f2bf(a) | ((unsigned)f2bf(b) << 16); }
DEV float sigm(float x) { return 1.f / (1.f + __expf(-x)); }
DEV float logsigm(float x) { return fminf(x, 0.f) - log1pf(expf(-fabsf(x))); }
DEV int row_bi(int m) { return m < M_LAT ? (m >> 12) : 4; }
DEV float wave_sum(float v) {
#pragma unroll
  for (int o = 32; o >= 1; o >>= 1) v += __shfl_xor(v, o);
  return v;
}
DEV float quad_sum(float v) { v += __shfl_xor(v, 16); v += __shfl_xor(v, 32); return v; }
DEV float quad_max(float v) { v = fmaxf(v, __shfl_xor(v, 16)); v = fmaxf(v, __shfl_xor(v, 32)); return v; }

template <int NT, int KS>
DEV void wave_mma(const bf16_t* pa, const bf16_t* pb, int ldb, f32x4 (&acc)[NT]) {
#pragma unroll
  for (int ks = 0; ks < KS; ++ks) {
    __builtin_amdgcn_sched_barrier(0);
    bf16x8 a = *(const bf16x8*)(pa + ks * 32);
#pragma unroll
    for (int ni = 0; ni < NT; ++ni) {
      bf16x8 b = *(const bf16x8*)(pb + ni * 16 * ldb + ks * 32);
      acc[ni] = __builtin_amdgcn_mfma_f32_16x16x32_bf16(b, a, acc[ni], 0, 0, 0);
    }
  }
}

constexpr int LDSS = 72;
template <int NI>
DEV void gemm_mainloop(const bf16_t* __restrict__ A, int lda, const bf16_t* __restrict__ Bt, int ldb, int K, int m0, int n0,
                       f32x4 (&acc)[4][NI], char* smem) {
  constexpr int TN = NI * 32;
  bf16_t* sA = (bf16_t*)smem;
  bf16_t* sB = sA + 2 * 128 * LDSS;
  const int tid = otid(), lane = tid & 63, wid = tid >> 6, wm = wid >> 1, wn = wid & 1, fr = lane & 15, fq = lane >> 4;
  uint4 ra[4], rb[NI];
  const bf16_t* Ap = A + (size_t)m0 * lda;
  const bf16_t* Bp = Bt + (size_t)n0 * ldb;
  const int lrow = tid >> 3, lkc = (tid & 7) * 8;
  __syncthreads();
#pragma unroll
  for (int i = 0; i < 4; ++i) ra[i] = *(const uint4*)(Ap + (size_t)(lrow + 32 * i) * lda + lkc);
#pragma unroll
  for (int i = 0; i < NI; ++i) rb[i] = *(const uint4*)(Bp + (size_t)(lrow + 32 * i) * ldb + lkc);
#pragma unroll
  for (int i = 0; i < 4; ++i) *(uint4*)(sA + (lrow + 32 * i) * LDSS + lkc) = ra[i];
#pragma unroll
  for (int i = 0; i < NI; ++i) *(uint4*)(sB + (lrow + 32 * i) * LDSS + lkc) = rb[i];
  __syncthreads();
  const int nk = K >> 6;
  for (int kt = 0; kt < nk; ++kt) {
    const int buf = kt & 1;
    if (kt + 1 < nk) {
      const int k0 = (kt + 1) << 6;
#pragma unroll
      for (int i = 0; i < 4; ++i) ra[i] = *(const uint4*)(Ap + (size_t)(lrow + 32 * i) * lda + k0 + lkc);
#pragma unroll
      for (int i = 0; i < NI; ++i) rb[i] = *(const uint4*)(Bp + (size_t)(lrow + 32 * i) * ldb + k0 + lkc);
    }
    const bf16_t* ab = sA + buf * 128 * LDSS + (wm * 64 + fr) * LDSS + fq * 8;
    const bf16_t* bb = sB + buf * TN * LDSS + (wn * (TN / 2) + fr) * LDSS + fq * 8;
#pragma unroll
    for (int ks = 0; ks < 2; ++ks) {
      bf16x8 af[4], bfr[NI];
#pragma unroll
      for (int mi = 0; mi < 4; ++mi) af[mi] = *(const bf16x8*)(ab + mi * 16 * LDSS + ks * 32);
#pragma unroll
      for (int ni = 0; ni < NI; ++ni) bfr[ni] = *(const bf16x8*)(bb + ni * 16 * LDSS + ks * 32);
#pragma unroll
      for (int mi = 0; mi < 4; ++mi)
#pragma unroll
        for (int ni = 0; ni < NI; ++ni) acc[mi][ni] = __builtin_amdgcn_mfma_f32_16x16x32_bf16(bfr[ni], af[mi], acc[mi][ni], 0, 0, 0);
    }
    if (kt + 1 < nk) {
      bf16_t* dA = sA + (buf ^ 1) * 128 * LDSS;
      bf16_t* dB = sB + (buf ^ 1) * TN * LDSS;
#pragma unroll
      for (int i = 0; i < 4; ++i) *(uint4*)(dA + (lrow + 32 * i) * LDSS + lkc) = ra[i];
#pragma unroll
      for (int i = 0; i < NI; ++i) *(uint4*)(dB + (lrow + 32 * i) * LDSS + lkc) = rb[i];
    }
    __syncthreads();
  }
}
template <int NI>
DEV void zero_acc(f32x4 (&acc)[4][NI]) {
#pragma unroll
  for (int mi = 0; mi < 4; ++mi)
#pragma unroll
    for (int ni = 0; ni < NI; ++ni) acc[mi][ni] = (f32x4){0.f, 0.f, 0.f, 0.f};
}
template <int NI, class F>
DEV void gemm_epi(f32x4 (&acc)[4][NI], int m0, int n0, F f) {
  const int tid = otid(), lane = tid & 63, wid = tid >> 6, wm = wid >> 1, wn = wid & 1, fr = lane & 15, fq = lane >> 4;
#pragma unroll
  for (int mi = 0; mi < 4; ++mi)
#pragma unroll
    for (int ni = 0; ni < NI; ++ni) f(m0 + wm * 64 + mi * 16 + fr, n0 + wn * (NI * 16) + ni * 16 + fq * 4, acc[mi][ni]);
}

DEV int colmap(int mode, int n) {
  if (mode == 0) return n;
  if (mode == 2) return n + 4368;
  if (n < 2816) return n;
  if (n < 4352) return n + 16;
  if (n < 4368) return n - 4352 + 2816;
  return -1;
}
DEV void cvt_job(const float* __restrict__ src, int ld, int K, int Npad, bf16_t* __restrict__ dst, int mode, char* smem) {
  float* t = (float*)smem;
  const int tid = otid(), ntn = Npad >> 6, ntiles = (K >> 6) * ntn;
  for (int tile = blockIdx.x; tile < ntiles; tile += gridDim.x) {
    const int k0 = (tile / ntn) << 6, n0 = (tile % ntn) << 6;
    __syncthreads();
    const int col = tid & 63, sc = colmap(mode, n0 + col);
#pragma unroll 4
    for (int r = 0; r < 16; ++r) {
      const int row = r * 4 + (tid >> 6);
      t[row * 65 + col] = sc >= 0 ? src[(size_t)(k0 + row) * ld + sc] : 0.f;
    }
    __syncthreads();
#pragma unroll
    for (int s = 0; s < 2; ++s) {
      const int slot = tid + 256 * s, n = slot >> 3, kg = slot & 7;
      uint4 v;
      v.x = pack2(t[(kg * 8 + 0) * 65 + n], t[(kg * 8 + 1) * 65 + n]);
      v.y = pack2(t[(kg * 8 + 2) * 65 + n], t[(kg * 8 + 3) * 65 + n]);
      v.z = pack2(t[(kg * 8 + 4) * 65 + n], t[(kg * 8 + 5) * 65 + n]);
      v.w = pack2(t[(kg * 8 + 6) * 65 + n], t[(kg * 8 + 7) * 65 + n]);
      *(uint4*)(dst + (size_t)(n0 + n) * K + k0 + kg * 8) = v;
    }
  }
}

DEV void phase0(KP p, char* smem) {
  const int tid = otid(), gtid = blockIdx.x * NTH + tid, gsz = gridDim.x * NTH;
  float* X = (float*)(p->ws + OFF_X);
  for (int i = gtid; i < M_ALL * D / 4; i += gsz) {
    float4 v = i < M_LAT * D / 4 ? ((const float4*)p->x)[i] : ((const float4*)p->ctx)[i - M_LAT * D / 4];
    ((float4*)X)[i] = v;
  }
  float2* TW = (float2*)(p->ws + OFF_TW);
  for (int i = gtid; i < 4096; i += gsz) { float s, c; sincospif((float)i / 4096.f, &s, &c); TW[i] = make_float2(c, -s); }
  float* ROPE = (float*)(p->ws + OFF_ROPE);
  for (int i = gtid; i < 4096 * 32; i += gsz) {
    const int pos = i >> 5, f = i & 31;
    const float inv = powf(10000.f, -(float)(f & 15) / 16.f);
    const float ang = (f < 16 ? (float)(pos >> 6) : (float)(pos & 63)) * inv;
    ROPE[pos * 64 + f] = cosf(ang); ROPE[pos * 64 + 32 + f] = sinf(ang);
  }
  {
    float* HID = (float*)(p->ws + OFF_HID);
    float* sz = (float*)smem;
    float* sh = sz + 4 * 36;
    const int sub = tid >> 6, j = tid & 63;
    for (int it = blockIdx.x; it < 4 * 4352 / 4; it += gridDim.x) {
      const int item = it * 4 + sub, l = item / 4352, tt = item % 4352;
      const bool isc = tt >= 4096; const int t = isc ? tt - 4096 : tt; const int Lx = isc ? LC : L;
      __syncthreads();
      if (j < 33) {
        float z;
        if (j == 0) z = (float)t / (float)(Lx - 1);
        else {
          const int bidx = (j - 1) & 15;
          const float band = 1e-4f + (15.f - 1e-4f) * (float)bidx / 15.f;
          const float w = 2.0f * 3.14159265358979323846f * (float)t / (float)Lx;
          z = j <= 16 ? cosf(w * band) : -sinf(w * band);
        }
        sz[sub * 36 + j] = z;
      }
      __syncthreads();
      const float* w1 = p->hy_w1 + (size_t)l * 33 * 64; const float* w2 = p->hy_w2 + (size_t)l * 64 * 64;
      float a = p->hy_b1[l * 64 + j];
      for (int k = 0; k < 33; ++k) a += sz[sub * 36 + k] * w1[k * 64 + j];
      sh[sub * 64 + j] = sinf(p->hy_freq[l * 128 + j] * a);
      __syncthreads();
      float b = p->hy_b2[l * 64 + j];
      for (int k = 0; k < 64; ++k) b += sh[sub * 64 + k] * w2[k * 64 + j];
      HID[((size_t)l * 4352 + tt) * 64 + j] = sinf(p->hy_freq[l * 128 + 64 + j] * b);
    }
  }
  if (blockIdx.x < 384) {
    float* ssc = (float*)smem;
    float* red = ssc + 5 * 1024;
    __syncthreads();
    for (int i = tid; i < 5 * 1024; i += NTH) { const float v = i < 4096 ? p->c[i] : p->c_ctx[i - 4096]; ssc[i] = v * sigm(v); }
    __syncthreads();
    float* MOD = (float*)(p->ws + OFF_MOD);
    for (int it = blockIdx.x; it < 384; it += gridDim.x) {
      const int l = it / 96, cb = it % 96, col = cb * 64 + (tid & 63), kg = tid >> 6;
      const float* w = p->ada_w + (size_t)l * 1024 * 6144 + col;
      float a0 = 0, a1 = 0, a2 = 0, a3 = 0, a4 = 0;
#pragma unroll 8
      for (int k = kg * 256; k < kg * 256 + 256; ++k) {
        const float wv = w[(size_t)k * 6144];
        a0 += ssc[k] * wv; a1 += ssc[1024 + k] * wv; a2 += ssc[2048 + k] * wv; a3 += ssc[3072 + k] * wv; a4 += ssc[4096 + k] * wv;
      }
      __syncthreads();
      red[(kg * 5 + 0) * 64 + (tid & 63)] = a0; red[(kg * 5 + 1) * 64 + (tid & 63)] = a1; red[(kg * 5 + 2) * 64 + (tid & 63)] = a2;
      red[(kg * 5 + 3) * 64 + (tid & 63)] = a3; red[(kg * 5 + 4) * 64 + (tid & 63)] = a4;
      __syncthreads();
      for (int o = tid; o < 320; o += NTH) {
        const int bi = o >> 6, cc = o & 63;
        const float s = red[(0 * 5 + bi) * 64 + cc] + red[(1 * 5 + bi) * 64 + cc] + red[(2 * 5 + bi) * 64 + cc] + red[(3 * 5 + bi) * 64 + cc];
        MOD[((size_t)l * 5 + bi) * 6144 + cb * 64 + cc] = s + p->ada_b[l * 6144 + cb * 64 + cc];
      }
    }
  }
}

DEV void norm_mod_phase(KP p, int l, const float* gain, int sh_off, int sc_off, int nrows) {
  const float* X = (const float*)(p->ws + OFF_X);
  bf16_t* A = (bf16_t*)(p->ws + OFF_A);
  const float* MOD = (const float*)(p->ws + OFF_MOD) + (size_t)l * 5 * 6144;
  const int lane = threadIdx.x & 63, gw = blockIdx.x * 4 + (threadIdx.x >> 6), nw = gridDim.x * 4;
  for (int m = gw; m < nrows; m += nw) {
    const float4* xr = (const float4*)(X + (size_t)m * D);
    float4 v[4]; float ss = 0.f;
#pragma unroll
    for (int i = 0; i < 4; ++i) { v[i] = xr[lane + 64 * i]; ss += v[i].x * v[i].x + v[i].y * v[i].y + v[i].z * v[i].z + v[i].w * v[i].w; }
    ss = wave_sum(ss);
    const float inv = rsqrtf(ss * (1.f / D) + EPS);
    const float* mo = MOD + (size_t)row_bi(m) * 6144;
#pragma unroll
    for (int i = 0; i < 4; ++i) {
      const int n = (lane + 64 * i) * 4;
      const float4 g = *(const float4*)(gain + n), sh = *(const float4*)(mo + sh_off + n), sc = *(const float4*)(mo + sc_off + n);
      uint2 o;
      o.x = pack2(v[i].x * inv * g.x * (1.f + sc.x) + sh.x, v[i].y * inv * g.y * (1.f + sc.y) + sh.y);
      o.y = pack2(v[i].z * inv * g.z * (1.f + sc.z) + sh.z, v[i].w * inv * g.w * (1.f + sc.w) + sh.w);
      *(uint2*)(A + (size_t)m * D + n) = o;
    }
  }
}

template <int NIT>
DEV void filt_item(KP p, int l, int q, bool isc, char* smem) {
  constexpr int Lx = NIT * 256;
  const int tid = otid(), lane = tid & 63, wid = tid >> 6;
  float4* sW = (float4*)smem;
  float* sred = (float*)(smem + 1024);
  __syncthreads();
  if (tid < 64) { const float* w3 = p->hy_w3 + ((size_t)l * 64 + tid) * 2048 + q * 4; sW[tid] = *(const float4*)w3; }
  __syncthreads();
  const float* HID = (const float*)(p->ws + OFF_HID) + ((size_t)l * 4352 + (isc ? 4096 : 0)) * 64;
  float r[NIT][4]; float s0 = 0, s1 = 0, s2 = 0, s3 = 0;
  const int c0 = (q * 4) & 511;
  const float a0 = logf(0.01f) / 1.5f, a1 = logf(0.01f) / 0.3f;
  float dl[4];
#pragma unroll
  for (int e = 0; e < 4; ++e) dl[e] = fabsf(a0 + (a1 - a0) * (float)(c0 + e) / 511.f);
#pragma unroll
  for (int i = 0; i < NIT; ++i) {
    const int t = tid + 256 * i;
    const float4* hr = (const float4*)(HID + (size_t)t * 64);
    float x0 = 0, x1 = 0, x2 = 0, x3 = 0;
#pragma unroll 4
    for (int j4 = 0; j4 < 16; ++j4) {
      const float4 h = hr[j4];
      float4 w;
      w = sW[j4 * 4 + 0]; x0 += h.x * w.x; x1 += h.x * w.y; x2 += h.x * w.z; x3 += h.x * w.w;
      w = sW[j4 * 4 + 1]; x0 += h.y * w.x; x1 += h.y * w.y; x2 += h.y * w.z; x3 += h.y * w.w;
      w = sW[j4 * 4 + 2]; x0 += h.z * w.x; x1 += h.z * w.y; x2 += h.z * w.z; x3 += h.z * w.w;
      w = sW[j4 * 4 + 3]; x0 += h.w * w.x; x1 += h.w * w.y; x2 += h.w * w.z; x3 += h.w * w.w;
    }
    const float tn = (float)t / (float)(Lx - 1);
    x0 *= expf(-tn * dl[0]); x1 *= expf(-tn * dl[1]); x2 *= expf(-tn * dl[2]); x3 *= expf(-tn * dl[3]);
    r[i][0] = x0; r[i][1] = x1; r[i][2] = x2; r[i][3] = x3;
    s0 += fabsf(x0); s1 += fabsf(x1); s2 += fabsf(x2); s3 += fabsf(x3);
  }
  s0 = wave_sum(s0); s1 = wave_sum(s1); s2 = wave_sum(s2); s3 = wave_sum(s3);
  if (lane == 0) { sred[wid * 4 + 0] = s0; sred[wid * 4 + 1] = s1; sred[wid * 4 + 2] = s2; sred[wid * 4 + 3] = s3; }
  __syncthreads();
  float inv[4];
#pragma unroll
  for (int e = 0; e < 4; ++e) inv[e] = 1.f / (sred[e] + sred[4 + e] + sred[8 + e] + sred[12 + e]);
  float* F = (float*)(p->ws + (isc ? OFF_FILTC : OFF_FILT));
#pragma unroll
  for (int i = 0; i < NIT; ++i) {
    const int t = tid + 256 * i;
#pragma unroll
    for (int e = 0; e < 4; ++e) F[(size_t)(q * 4 + e) * Lx + t] = r[i][e] * inv[e];
  }
}

template <int LOGN>
DEV void fft_dif(float2* z, const float2* __restrict__ TW) {
  constexpr int N = 1 << LOGN;
  for (int lh = LOGN - 1; lh >= 0; --lh) {
    const int h = 1 << lh;
    for (int j = threadIdx.x; j < N / 2; j += NTH) {
      const int pos = j & (h - 1), i0 = ((j >> lh) << (lh + 1)) + pos, i1 = i0 + h;
      const float2 w = TW[pos << (12 - lh)];
      const float2 a = z[i0], b = z[i1];
      z[i0] = make_float2(a.x + b.x, a.y + b.y);
      const float dx = a.x - b.x, dy = a.y - b.y;
      z[i1] = make_float2(dx * w.x - dy * w.y, dx * w.y + dy * w.x);
    }
    __syncthreads();
  }
}
template <int LOGN>
DEV void fft_dit_inv(float2* z, const float2* __restrict__ TW) {
  constexpr int N = 1 << LOGN;
  for (int lh = 0; lh < LOGN; ++lh) {
    const int h = 1 << lh;
    for (int j = threadIdx.x; j < N / 2; j += NTH) {
      const int pos = j & (h - 1), i0 = ((j >> lh) << (lh + 1)) + pos, i1 = i0 + h;
      const float2 w = TW[pos << (12 - lh)];
      const float2 a = z[i0], b0 = z[i1];
      const float bx = b0.x * w.x + b0.y * w.y, by = b0.y * w.x - b0.x * w.y;
      z[i0] = make_float2(a.x + bx, a.y + by);
      z[i1] = make_float2(a.x - bx, a.y - by);
    }
    __syncthreads();
  }
}
DEV float conv3(const bf16_t* __restrict__ row, int t, int Lx, float w0, float w1, float w2, float b) {
  const float xm = t > 0 ? bf2f(row[t - 1]) : 0.f, x0 = bf2f(row[t]), xp = t < Lx - 1 ? bf2f(row[t + 1]) : 0.f;
  return b + w0 * xm + w1 * x0 + w2 * xp;
}
template <int LOGN>
DEV void hyena_item(KP p, int l, int c, int pair, bool isc, char* smem) {
  constexpr int N = 1 << LOGN, Lx = N / 2, NPT = N / 256, LPT = Lx / 256;
  const int tid = otid();
  float2* z = (float2*)smem;
  const float2* TW = (const float2*)(p->ws + OFF_TW);
  const float* F = (const float*)(p->ws + (isc ? OFF_FILTC : OFF_FILT));
  const bf16_t* H = (const bf16_t*)(p->ws + (isc ? OFF_HYTC : OFF_HYT));
  bf16_t* HYO = (bf16_t*)(p->ws + OFF_HYO);
  const float* sw = p->hy_short_w + (size_t)l * 3 * 1536; const float* sb = p->hy_short_b + (size_t)l * 1536;
  const int b0 = 2 * pair, b1 = 2 * pair + 1;
  float2 G[NPT]; float2 z1[LPT];
  __syncthreads();
#pragma unroll 1
  for (int o = 0; o < 2; ++o) {
    {
      const float* hf = F + (size_t)((o * 2 + 0) * 512 + c) * Lx;
      const float* hb = F + (size_t)((o * 2 + 1) * 512 + c) * Lx;
      const float skip = p->hy_skip[(size_t)l * 1024 + o * 512 + c];
#pragma unroll 2
      for (int n = tid; n < N; n += 256) {
        float v;
        if (n < Lx) v = hf[n] + (n == 0 ? hb[0] + skip : 0.f);
        else if (n == Lx) v = 0.f;
        else v = hb[N - n];
        z[n] = make_float2(v, 0.f);
      }
    }
    __syncthreads();
    fft_dif<LOGN>(z, TW);
#pragma unroll
    for (int i = 0; i < NPT; ++i) G[i] = z[tid + 256 * i];
    __syncthreads();
    if (o == 0) {
      const int cc = 1024 + c;
      const float w0 = sw[cc], w1 = sw[1536 + cc], w2 = sw[3072 + cc], bb = sb[cc];
      const bf16_t* r0 = H + ((size_t)b0 * 1536 + cc) * Lx; const bf16_t* r1 = H + ((size_t)b1 * 1536 + cc) * Lx;
#pragma unroll 2
      for (int t = tid; t < Lx; t += 256) {
        z[t] = make_float2(conv3(r0, t, Lx, w0, w1, w2, bb), conv3(r1, t, Lx, w0, w1, w2, bb));
        z[t + Lx] = make_float2(0.f, 0.f);
      }
    } else {
#pragma unroll
      for (int i = 0; i < LPT; ++i) { const int t = tid + 256 * i; z[t] = z1[i]; z[t + Lx] = make_float2(0.f, 0.f); }
    }
    __syncthreads();
    fft_dif<LOGN>(z, TW);
#pragma unroll
    for (int i = 0; i < NPT; ++i) {
      const int n = tid + 256 * i; const float2 a = z[n], g = G[i];
      z[n] = make_float2(a.x * g.x - a.y * g.y, a.x * g.y + a.y * g.x);
    }
    __syncthreads();
    fft_dit_inv<LOGN>(z, TW);
    {
      const int cc = o * 512 + c;
      const float w0 = sw[cc], w1 = sw[1536 + cc], w2 = sw[3072 + cc], bb = sb[cc];
      const bf16_t* r0 = H + ((size_t)b0 * 1536 + cc) * Lx; const bf16_t* r1 = H + ((size_t)b1 * 1536 + cc) * Lx;
#pragma unroll 2
      for (int t = tid; t < Lx; t += 256) {
        const float2 y = z[t];
        const float o0 = conv3(r0, t, Lx, w0, w1, w2, bb) * y.x * (1.f / N), o1 = conv3(r1, t, Lx, w0, w1, w2, bb) * y.y * (1.f / N);
        if (o == 0) z[t] = make_float2(o0, o1);
        else {
          const size_t ra = isc ? (size_t)(M_LAT + b0 * LC + t) : (size_t)(b0 * L + t);
          const size_t rb = isc ? (size_t)(M_LAT + b1 * LC + t) : (size_t)(b1 * L + t);
          HYO[ra * 512 + c] = f2bf(o0); HYO[rb * 512 + c] = f2bf(o1);
        }
      }
      if (o == 0) {
#pragma unroll
        for (int i = 0; i < LPT; ++i) z1[i] = z[tid + 256 * i];
      }
    }
    __syncthreads();
  }
}

constexpr int AQ_LD = 72, AP_LD = 136;
DEV void attn_item(KP p, int l, int b, int qt, int qh, bool isc, char* smem) {
  const int tid = otid(), lane = tid & 63, w = tid >> 6, fr = lane & 15, fq = lane >> 4;
  const bf16_t* QKV = (const bf16_t*)(p->ws + OFF_QKV);
  const float* ROPE = (const float*)(p->ws + OFF_ROPE);
  bf16_t* ATT = (bf16_t*)(p->ws + OFF_ATT);
  bf16_t* sQ = (bf16_t*)smem;
  bf16_t* sVt = sQ + 128 * AQ_LD;
  bf16_t* sP = sVt + 64 * AP_LD;
  bf16_t* sK = sP;
  const int kv = qh >> 2;
  const int qrow0 = isc ? (M_LAT + b * LC + qt * 128) : (b * L + qt * 128);
  const int r2 = tid >> 1, hh = tid & 1;
  __syncthreads();
  {
    const bf16_t* src = QKV + (size_t)(qrow0 + r2) * 768 + qh * 64 + hh * 16;
    uint4 lo0 = *(const uint4*)(src), lo1 = *(const uint4*)(src + 8), hi0 = *(const uint4*)(src + 32), hi1 = *(const uint4*)(src + 40);
    bf16_t* d = sQ + r2 * AQ_LD + hh * 16;
    if (isc) { *(uint4*)d = lo0; *(uint4*)(d + 8) = lo1; *(uint4*)(d + 32) = hi0; *(uint4*)(d + 40) = hi1; }
    else {
      const float* rp = ROPE + (size_t)(qt * 128 + r2) * 64 + hh * 16;
      const bf16_t* a = (const bf16_t*)&lo0; const bf16_t* a2 = (const bf16_t*)&lo1; const bf16_t* c = (const bf16_t*)&hi0; const bf16_t* c2 = (const bf16_t*)&hi1;
#pragma unroll
      for (int i = 0; i < 16; ++i) {
        const float t1 = bf2f(i < 8 ? a[i] : a2[i - 8]), t2 = bf2f(i < 8 ? c[i] : c2[i - 8]);
        const float cs = rp[i], sn = rp[32 + i];
        d[i] = f2bf(t1 * cs - t2 * sn); d[32 + i] = f2bf(t2 * cs + t1 * sn);
      }
    }
  }
  float mrun[2], lrun[2];
  const float sink = p->att_sink[l * 8 + qh];
  mrun[0] = mrun[1] = sink; lrun[0] = lrun[1] = 1.f;
  f32x4 O[2][4];
#pragma unroll
  for (int mi = 0; mi < 2; ++mi)
#pragma unroll
    for (int ni = 0; ni < 4; ++ni) O[mi][ni] = (f32x4){0.f, 0.f, 0.f, 0.f};
  const int ntile = isc ? 2 : 5;
#pragma unroll 1
  for (int kt = 0; kt < ntile; ++kt) {
    int krow0, kpos0 = 0, mode = 0;
    bool rope = false;
    if (kt < 2) krow0 = M_LAT + b * LC + kt * 128;
    else {
      const int kb = qt - 1 + (kt - 2);
      if (kb < 0 || kb >= 32) continue;
      krow0 = b * L + kb * 128; kpos0 = kb * 128; rope = true; mode = kt == 2 ? 1 : (kt == 4 ? 2 : 0);
    }
    __syncthreads();
    {
      const bf16_t* src = QKV + (size_t)(krow0 + r2) * 768 + 512 + kv * 64 + hh * 16;
      uint4 lo0 = *(const uint4*)(src), lo1 = *(const uint4*)(src + 8), hi0 = *(const uint4*)(src + 32), hi1 = *(const uint4*)(src + 40);
      bf16_t* d = sK + r2 * AQ_LD + hh * 16;
      if (!rope) { *(uint4*)d = lo0; *(uint4*)(d + 8) = lo1; *(uint4*)(d + 32) = hi0; *(uint4*)(d + 40) = hi1; }
      else {
        const float* rp = ROPE + (size_t)(kpos0 + r2) * 64 + hh * 16;
        const bf16_t* a = (const bf16_t*)&lo0; const bf16_t* a2 = (const bf16_t*)&lo1; const bf16_t* c = (const bf16_t*)&hi0; const bf16_t* c2 = (const bf16_t*)&hi1;
#pragma unroll
        for (int i = 0; i < 16; ++i) {
          const float t1 = bf2f(i < 8 ? a[i] : a2[i - 8]), t2 = bf2f(i < 8 ? c[i] : c2[i - 8]);
          const float cs = rp[i], sn = rp[32 + i];
          d[i] = f2bf(t1 * cs - t2 * sn); d[32 + i] = f2bf(t2 * cs + t1 * sn);
        }
      }
      const bf16_t* vs = QKV + (size_t)(krow0 + r2) * 768 + 640 + kv * 64 + hh * 32;
      uint4 v4[4];
#pragma unroll
      for (int i = 0; i < 4; ++i) v4[i] = *(const uint4*)(vs + 8 * i);
      const bf16_t* ve = (const bf16_t*)v4;
#pragma unroll
      for (int i = 0; i < 32; ++i) sVt[(hh * 32 + i) * AP_LD + r2] = ve[i];
    }
    __syncthreads();
    f32x4 S[2][8];
#pragma unroll
    for (int mi = 0; mi < 2; ++mi) {
#pragma unroll
      for (int ni = 0; ni < 8; ++ni) S[mi][ni] = (f32x4){0.f, 0.f, 0.f, 0.f};
      wave_mma<8, 2>(sQ + (w * 32 + mi * 16 + fr) * AQ_LD + fq * 8, sK + fr * AQ_LD + fq * 8, AQ_LD, S[mi]);
    }
    __syncthreads();
#pragma unroll
    for (int mi = 0; mi < 2; ++mi) {
      const int tau = w * 32 + mi * 16 + fr;
      float mx = -INFINITY;
#pragma unroll
      for (int ni = 0; ni < 8; ++ni)
#pragma unroll
        for (int j = 0; j < 4; ++j) {
          const int s = ni * 16 + fq * 4 + j;
          float v = S[mi][ni][j] * 0.125f;
          if ((mode == 1 && s < tau) || (mode == 2 && s > tau)) v = -INFINITY;
          S[mi][ni][j] = v; mx = fmaxf(mx, v);
        }
      mx = quad_max(mx);
      const float mnew = fmaxf(mrun[mi], mx), alpha = __expf(mrun[mi] - mnew);
      float rs = 0.f;
#pragma unroll
      for (int ni = 0; ni < 8; ++ni) {
        const float p0 = __expf(S[mi][ni][0] - mnew), p1 = __expf(S[mi][ni][1] - mnew), p2 = __expf(S[mi][ni][2] - mnew), p3 = __expf(S[mi][ni][3] - mnew);
        rs += p0 + p1 + p2 + p3;
        uint2 pk; pk.x = pack2(p0, p1); pk.y = pack2(p2, p3);
        *(uint2*)(sP + tau * AP_LD + ni * 16 + fq * 4) = pk;
      }
      rs = quad_sum(rs);
      lrun[mi] = lrun[mi] * alpha + rs; mrun[mi] = mnew;
#pragma unroll
      for (int ni = 0; ni < 4; ++ni) O[mi][ni] *= alpha;
    }
    __syncthreads();
#pragma unroll
    for (int mi = 0; mi < 2; ++mi) wave_mma<4, 4>(sP + (w * 32 + mi * 16 + fr) * AP_LD + fq * 8, sVt + fr * AP_LD + fq * 8, AP_LD, O[mi]);
  }
#pragma unroll
  for (int mi = 0; mi < 2; ++mi) {
    const float il = 1.f / lrun[mi];
    const size_t row = (size_t)(qrow0 + w * 32 + mi * 16 + fr);
#pragma unroll
    for (int ni = 0; ni < 4; ++ni) {
      uint2 pk; pk.x = pack2(O[mi][ni][0] * il, O[mi][ni][1] * il); pk.y = pack2(O[mi][ni][2] * il, O[mi][ni][3] * il);
      *(uint2*)(ATT + row * 512 + qh * 64 + ni * 16 + fq * 4) = pk;
    }
  }
}

constexpr int ML_LD = 136;
constexpr float ML_SCALE = 0.08838834764831845f;
DEV int chunk_row0(int b, int cpos) { return cpos < 2 ? (M_LAT + b * LC + cpos * 128) : (b * L + (cpos - 2) * 128); }
DEV int scan_idx(int cpos, int dir) { return dir == 0 ? cpos : (cpos < 2 ? 1 - cpos : 35 - cpos); }
DEV void mlstm_prep(KP p, int l, int row0, int h, float* sb, float* sib, float* spm) {
  const int tid = otid();
  const float* MLG = (const float*)(p->ws + OFF_MLG);
  {
    const int dir = tid >> 7, s = tid & 127;
    const float gi = MLG[(size_t)(row0 + s) * 16 + dir * 8 + h] + p->ml_gate_b[l * 16 + dir * 8 + h];
    const float gf = MLG[(size_t)(row0 + s) * 16 + dir * 8 + 4 + h] + p->ml_gate_b[l * 16 + dir * 8 + 4 + h];
    sb[tid] = logsigm(gf); sib[tid] = gi;
  }
  __syncthreads();
  if (tid == 0) {
    float run = 0.f, mx = -INFINITY;
    for (int s = 0; s < 128; ++s) { run += sb[s]; sb[s] = run; const float ib = sib[s] - run; sib[s] = ib; mx = fmaxf(mx, ib); spm[s] = mx; }
  }
  if (tid == 64) {
    float run = 0.f, mx = -INFINITY;
    for (int s = 127; s >= 0; --s) { run += sb[128 + s]; sb[128 + s] = run; const float ib = sib[128 + s] - run; sib[128 + s] = ib; mx = fmaxf(mx, ib); spm[128 + s] = mx; }
  }
  __syncthreads();
}
DEV void mlstm_local_item(KP p, int l, int b, int h, int cpos, char* smem) {
  const int tid = otid(), lane = tid & 63, wid = tid >> 6, wm = wid >> 1, wn = wid & 1, fr = lane & 15, fq = lane >> 4;
  bf16_t* sKt = (bf16_t*)smem;
  bf16_t* sVt = sKt + 128 * ML_LD;
  float* sb = (float*)(sVt + 128 * ML_LD);
  float* sib = sb + 256; float* spm = sib + 256; float* sgl = spm + 256;
  const bf16_t* ML = (const bf16_t*)(p->ws + OFF_ML);
  float* STATES = (float*)(p->ws + OFF_STATES); float* STATS = (float*)(p->ws + OFF_STATS);
  const int row0 = chunk_row0(b, cpos);
  __syncthreads();
  mlstm_prep(p, l, row0, h, sb, sib, spm);
#pragma unroll 2
  for (int i = 0; i < 8; ++i) {
    const int id = tid + 256 * i, s = id >> 4, kc = id & 15;
    uint4 v = *(const uint4*)(ML + (size_t)(row0 + s) * 2048 + 512 + h * 128 + kc * 8);
    const bf16_t* e = (const bf16_t*)&v;
#pragma unroll
    for (int q = 0; q < 8; ++q) sKt[(kc * 8 + q) * ML_LD + s] = e[q];
  }
#pragma unroll 1
  for (int dir = 0; dir < 2; ++dir) {
    const int chain = (b * 4 + h) * 2 + dir, sidx = scan_idx(cpos, dir);
    const float bl = dir == 0 ? sb[127] : sb[128], maxib = dir == 0 ? spm[127] : spm[128];
    __syncthreads();
    if (tid < 128) sgl[tid] = __expf(sib[dir * 128 + tid] - maxib);
    __syncthreads();
#pragma unroll 2
    for (int i = 0; i < 8; ++i) {
      const int id = tid + 256 * i, s = id >> 4, vc = id & 15;
      uint4 v = *(const uint4*)(ML + (size_t)(row0 + s) * 2048 + 1024 + h * 128 + vc * 8);
      const bf16_t* e = (const bf16_t*)&v; const float g = sgl[s];
#pragma unroll
      for (int q = 0; q < 8; ++q) sVt[(vc * 8 + q) * ML_LD + s] = f2bf(g * bf2f(e[q]));
    }
    __syncthreads();
    float* dst = STATES + ((size_t)chain * 34 + sidx) * 16512;
#pragma unroll
    for (int mi = 0; mi < 4; ++mi) {
      f32x4 acc[4];
#pragma unroll
      for (int ni = 0; ni < 4; ++ni) acc[ni] = (f32x4){0.f, 0.f, 0.f, 0.f};
      wave_mma<4, 4>(sVt + (wm * 64 + mi * 16 + fr) * ML_LD + fq * 8, sKt + (wn * 64 + fr) * ML_LD + fq * 8, ML_LD, acc);
#pragma unroll
      for (int ni = 0; ni < 4; ++ni) *(f32x4*)(dst + (wm * 64 + mi * 16 + fr) * 128 + wn * 64 + ni * 16 + fq * 4) = acc[ni] * ML_SCALE;
    }
    if (tid < 128) {
      float a = 0.f;
      for (int s = 0; s < 128; ++s) a += sgl[s] * bf2f(sKt[tid * ML_LD + s]);
      dst[16384 + tid] = a * ML_SCALE;
    }
    if (tid == 0) { STATS[(chain * 34 + sidx) * 4 + 0] = bl; STATS[(chain * 34 + sidx) * 4 + 1] = bl + maxib; }
  }
}
DEV void mlstm_scan_phase(KP p) {
  float* STATES = (float*)(p->ws + OFF_STATES); float* STATS = (float*)(p->ws + OFF_STATS);
  const int gtid = blockIdx.x * NTH + threadIdx.x, gsz = gridDim.x * NTH;
  for (int i = gtid; i < 32 * 16512; i += gsz) {
    const int chain = i / 16512, e = i % 16512;
    float* base = STATES + (size_t)chain * 34 * 16512 + e;
    const float* st = STATS + chain * 34 * 4;
    float m = 0.f, S = 0.f;
#pragma unroll 1
    for (int half = 0; half < 2; ++half) {
      float lc[17];
#pragma unroll
      for (int k = 0; k < 17; ++k) lc[k] = base[(size_t)(half * 17 + k) * 16512];
#pragma unroll
      for (int k = 0; k < 17; ++k) {
        const int sidx = half * 17 + k;
        const float bl = st[sidx * 4 + 0], ms = st[sidx * 4 + 1];
        base[(size_t)sidx * 16512] = S;
        if (e == 0) STATS[(chain * 34 + sidx) * 4 + 2] = m;
        const float mn = fmaxf(bl + m, ms);
        S = __expf(bl + m - mn) * S + __expf(ms - mn) * lc[k];
        m = mn;
      }
    }
  }
}
DEV void mlstm_out_item(KP p, int l, int b, int h, int cpos, int half, char* smem) {
  const int tid = otid(), lane = tid & 63, w = tid >> 6, fr = lane & 15, fq = lane >> 4;
  bf16_t* sQ = (bf16_t*)smem;
  bf16_t* sP = sQ + 64 * ML_LD;
  bf16_t* sR = sP + 64 * ML_LD;
  float* sb = (float*)(sR + 128 * ML_LD); float* sib = sb + 256; float* spm = sib + 256; float* sn = spm + 256;
  const bf16_t* ML = (const bf16_t*)(p->ws + OFF_ML);
  const float* STATES = (const float*)(p->ws + OFF_STATES); const float* STATS = (const float*)(p->ws + OFF_STATS);
  bf16_t* MLS = (bf16_t*)(p->ws + OFF_MLS);
  const int row0 = chunk_row0(b, cpos);
  __syncthreads();
  mlstm_prep(p, l, row0, h, sb, sib, spm);
#pragma unroll
  for (int i = 0; i < 4; ++i) {
    const int id = tid + 256 * i, r = id >> 4, kc = id & 15;
    *(uint4*)(sQ + r * ML_LD + kc * 8) = *(const uint4*)(ML + (size_t)(row0 + half * 64 + r) * 2048 + h * 128 + kc * 8);
  }
  f32x4 hs[8];
#pragma unroll
  for (int ni = 0; ni < 8; ++ni) hs[ni] = (f32x4){0.f, 0.f, 0.f, 0.f};
  const int tl = half * 64 + w * 16 + fr;
#pragma unroll 1
  for (int dir = 0; dir < 2; ++dir) {
    const int chain = (b * 4 + h) * 2 + dir, sidx = scan_idx(cpos, dir);
    const float m_in = STATS[(chain * 34 + sidx) * 4 + 2];
    __syncthreads();
#pragma unroll 2
    for (int i = 0; i < 8; ++i) {
      const int id = tid + 256 * i, r = id >> 4, kc = id & 15;
      *(uint4*)(sR + r * ML_LD + kc * 8) = *(const uint4*)(ML + (size_t)(row0 + r) * 2048 + 512 + h * 128 + kc * 8);
    }
    __syncthreads();
    f32x4 acc[8];
#pragma unroll
    for (int ni = 0; ni < 8; ++ni) acc[ni] = (f32x4){0.f, 0.f, 0.f, 0.f};
    wave_mma<8, 4>(sQ + (w * 16 + fr) * ML_LD + fq * 8, sR + fr * ML_LD + fq * 8, ML_LD, acc);
    const float bt = sb[dir * 128 + tl], pmx = spm[dir * 128 + tl];
    const float mt = fmaxf(bt + m_in, bt + pmx);
    float rs = 0.f;
#pragma unroll
    for (int ni = 0; ni < 8; ++ni) {
      float pv[4];
#pragma unroll
      for (int j = 0; j < 4; ++j) {
        const int s = ni * 16 + fq * 4 + j;
        const bool valid = dir == 0 ? (s <= tl) : (s >= tl);
        const float e = valid ? __expf(bt + sib[dir * 128 + s] - mt) : 0.f;
        pv[j] = acc[ni][j] * ML_SCALE * e; rs += pv[j];
      }
      uint2 pk; pk.x = pack2(pv[0], pv[1]); pk.y = pack2(pv[2], pv[3]);
      *(uint2*)(sP + (w * 16 + fr) * ML_LD + ni * 16 + fq * 4) = pk;
    }
    rs = quad_sum(rs);
    __syncthreads();
    const float* Cs = STATES + ((size_t)chain * 34 + sidx) * 16512;
#pragma unroll 2
    for (int i = 0; i < 16; ++i) {
      const int id = tid + 256 * i, r = id >> 5, kc = id & 31;
      const float4 v = *(const float4*)(Cs + r * 128 + kc * 4);
      uint2 pk; pk.x = pack2(v.x, v.y); pk.y = pack2(v.z, v.w);
      *(uint2*)(sR + r * ML_LD + kc * 4) = pk;
    }
    if (tid < 128) sn[tid] = Cs[16384 + tid];
    __syncthreads();
#pragma unroll
    for (int ni = 0; ni < 8; ++ni) acc[ni] = (f32x4){0.f, 0.f, 0.f, 0.f};
    wave_mma<8, 4>(sQ + (w * 16 + fr) * ML_LD + fq * 8, sR + fr * ML_LD + fq * 8, ML_LD, acc);
    float qn = 0.f;
#pragma unroll 8
    for (int k = 0; k < 32; ++k) qn += bf2f(sQ[(w * 16 + fr) * ML_LD + fq * 32 + k]) * sn[fq * 32 + k];
    qn = quad_sum(qn);
    const float wi = __expf(bt + m_in - mt);
#pragma unroll
    for (int ni = 0; ni < 8; ++ni) acc[ni] *= wi;
    __syncthreads();
#pragma unroll 2
    for (int i = 0; i < 8; ++i) {
      const int id = tid + 256 * i, s = id >> 4, vc = id & 15;
      uint4 v = *(const uint4*)(ML + (size_t)(row0 + s) * 2048 + 1024 + h * 128 + vc * 8);
      const bf16_t* e = (const bf16_t*)&v;
#pragma unroll
      for (int q = 0; q < 8; ++q) sR[(vc * 8 + q) * ML_LD + s] = e[q];
    }
    __syncthreads();
    wave_mma<8, 4>(sP + (w * 16 + fr) * ML_LD + fq * 8, sR + fr * ML_LD + fq * 8, ML_LD, acc);
    const float den = wi * qn + rs;
    const float idd = 1.f / fmaxf(fabsf(den), __expf(-mt));
#pragma unroll
    for (int ni = 0; ni < 8; ++ni) hs[ni] += acc[ni] * idd;
  }
  float ss = 0.f;
#pragma unroll
  for (int ni = 0; ni < 8; ++ni) ss += hs[ni][0] * hs[ni][0] + hs[ni][1] * hs[ni][1] + hs[ni][2] * hs[ni][2] + hs[ni][3] * hs[ni][3];
  ss = quad_sum(ss);
  const float inv = rsqrtf(ss * (1.f / 128.f) + EPS);
  const size_t row = (size_t)(row0 + tl);
#pragma unroll
  for (int ni = 0; ni < 8; ++ni) {
    const int v0 = ni * 16 + fq * 4;
    const float4 g = *(const float4*)(p->ml_norm_g + (size_t)l * 512 + h * 128 + v0);
    const uint2 ob = *(const uint2*)(ML + row * 2048 + 1536 + h * 128 + v0);
    const float o0 = bf2f((bf16_t)(ob.x & 0xffff)), o1 = bf2f((bf16_t)(ob.x >> 16)), o2 = bf2f((bf16_t)(ob.y & 0xffff)), o3 = bf2f((bf16_t)(ob.y >> 16));
    uint2 pk;
    pk.x = pack2(hs[ni][0] * inv * g.x * sigm(o0), hs[ni][1] * inv * g.y * sigm(o1));
    pk.y = pack2(hs[ni][2] * inv * g.z * sigm(o2), hs[ni][3] * inv * g.w * sigm(o3));
    *(uint2*)(MLS + row * 512 + h * 128 + v0) = pk;
  }
}

__global__ void __launch_bounds__(NTH, 1) fwd_megakernel(Params p_unused) {
  cg::grid_group grid = cg::this_grid();
  __shared__ __attribute__((aligned(16))) char smem[SMEM_BYTES];
  const int tid = otid(), nblk = gridDim.x, bid = blockIdx.x;
  KP kp = (KP)__builtin_amdgcn_kernarg_segment_ptr();
  char* ws = kp->ws;
  float* X = (float*)(ws + OFF_X);
  bf16_t* A = (bf16_t*)(ws + OFF_A);

  phase0(lp(kp), smem);
  grid.sync();

#pragma unroll 1
  for (int l = 0; l < 4; ++l) {
    const bool need_ctx = l < 3;
    const int mtiles = need_ctx ? 136 : 128;
    const float* MOD = (const float*)(ws + OFF_MOD) + (size_t)l * 5 * 6144;
    cvt_job(lp(kp)->w_in + (size_t)l * 1024 * N_IN, N_IN, 1024, N_INP, (bf16_t*)(ws + OFF_WIN), 1, smem);
    cvt_job(lp(kp)->w_in + (size_t)l * 1024 * N_IN, N_IN, 1024, 3072, (bf16_t*)(ws + OFF_WG), 2, smem);
    for (int r = 0; r < 3; ++r)
      cvt_job(lp(kp)->w_branch + ((size_t)l * 3 + r) * 512 * 1024, 1024, 512, 1024, (bf16_t*)(ws + OFF_WBR) + (size_t)r * 1024 * 512, 0, smem);
    cvt_job(lp(kp)->w_out + (size_t)l * 1024 * 1024, 1024, 1024, 1024, (bf16_t*)(ws + OFF_WOUT), 0, smem);
    cvt_job(lp(kp)->w_up + (size_t)l * 1024 * 5632, 5632, 1024, 5632, (bf16_t*)(ws + OFF_WUP), 0, smem);
    cvt_job(lp(kp)->w_down + (size_t)l * 2816 * 1024, 1024, 2816, 1024, (bf16_t*)(ws + OFF_WDN), 0, smem);
    for (int it = bid; it < 1024; it += nblk) {
#ifndef NO_FILT
      if (it < 512) filt_item<16>(lp(kp), l, it, false, smem);
      else filt_item<1>(lp(kp), l, it - 512, true, smem);
#endif
    }
    norm_mod_phase(lp(kp), l, lp(kp)->norm1_g + (size_t)l * D, 0, 1024, M_ALL);
    grid.sync();
    {
      const bf16_t* Wt = (const bf16_t*)(ws + OFF_WIN);
      bf16_t* QKV = (bf16_t*)(ws + OFF_QKV); bf16_t* ML = (bf16_t*)(ws + OFF_ML); float* MLG = (float*)(ws + OFF_MLG);
      bf16_t* HYT = (bf16_t*)(ws + OFF_HYT); bf16_t* HYTC = (bf16_t*)(ws + OFF_HYTC);
      for (int tile = bid; tile < 136 * 35; tile += nblk) {
        const int mt = tile / 35, nt = tile % 35, m0 = mt * 128, n0 = nt * 128;
        f32x4 acc[4][4]; zero_acc<4>(acc);
        gemm_mainloop<4>(A, D, Wt, D, D, m0, n0, acc, smem);
        if (nt < 6) gemm_epi<4>(acc, m0, n0, [&](int m, int n, f32x4 v) {
          uint2 pk; pk.x = pack2(v[0], v[1]); pk.y = pack2(v[2], v[3]); *(uint2*)(QKV + (size_t)m * 768 + n) = pk; });
        else if (nt < 22) gemm_epi<4>(acc, m0, n0, [&](int m, int n, f32x4 v) {
          uint2 pk; pk.x = pack2(v[0], v[1]); pk.y = pack2(v[2], v[3]); *(uint2*)(ML + (size_t)m * 2048 + (n - 768)) = pk; });
        else if (nt < 34) gemm_epi<4>(acc, m0, n0, [&](int m, int n, f32x4 v) {
          const int hc = n - 2816;
          if (m < M_LAT) { const int b = m >> 12, t = m & 4095;
#pragma unroll
            for (int j = 0; j < 4; ++j) HYT[((size_t)b * 1536 + hc + j) * L + t] = f2bf(v[j]); }
          else { const int mc = m - M_LAT, b = mc >> 8, t = mc & 255;
#pragma unroll
            for (int j = 0; j < 4; ++j) HYTC[((size_t)b * 1536 + hc + j) * LC + t] = f2bf(v[j]); } });
        else gemm_epi<4>(acc, m0, n0, [&](int m, int n, f32x4 v) { const int gc = n - 4352; if (gc < 16) *(f32x4*)(MLG + (size_t)m * 16 + gc) = v; });
      }
    }
    grid.sync();
    {
      const int n_hl = 1024, n_al = 1024, n_ml = 544, n_hc = need_ctx ? 1024 : 0, n_ac = need_ctx ? 64 : 0;
      const int total = n_hl + n_al + n_ml + n_hc + n_ac;
      for (int it = bid; it < total; it += nblk) {
        int i = it;
#ifndef NO_HY
        if (i < n_hl) { hyena_item<13>(lp(kp), l, i >> 1, i & 1, false, smem); continue; }
#endif
        i -= n_hl;
#ifndef NO_ATT
        if (i < n_al) { attn_item(lp(kp), l, i >> 8, (i >> 3) & 31, i & 7, false, smem); continue; }
#endif
        i -= n_al;
#ifndef NO_MLL
        if (i < n_ml) { mlstm_local_item(lp(kp), l, i / 136, (i / 34) & 3, i % 34, smem); continue; }
#endif
        i -= n_ml;
#ifndef NO_HYC
        if (i < n_hc) { hyena_item<9>(lp(kp), l, i >> 1, i & 1, true, smem); continue; }
#endif
        i -= n_hc;
#ifndef NO_ATT
        attn_item(lp(kp), l, i >> 4, (i >> 3) & 1, i & 7, true, smem);
#endif
      }
    }
    grid.sync();
#ifndef NO_SCAN
    mlstm_scan_phase(lp(kp));
#endif
    grid.sync();
    {
      const int c0 = need_ctx ? 0 : 2, ncp = 34 - c0;
      for (int it = bid; it < 16 * ncp * 2; it += nblk) {
        const int half = it & 1, r = it >> 1, cpos = c0 + r % ncp, bh = r / ncp;
#ifndef NO_MLO
        mlstm_out_item(lp(kp), l, bh >> 2, bh & 3, cpos, half, smem);
#endif
      }
    }
    grid.sync();
    {
      bf16_t* Y = (bf16_t*)(ws + OFF_Y);
      const bf16_t* Wg = (const bf16_t*)(ws + OFF_WG); const bf16_t* Wb = (const bf16_t*)(ws + OFF_WBR);
      for (int tile = bid; tile < mtiles * 16; tile += nblk) {
        const int m0 = (tile >> 4) * 128, n0 = (tile & 15) * 64;
        f32x4 y[4][2]; zero_acc<2>(y);
#pragma unroll 1
        for (int r = 0; r < 3; ++r) {
          const bf16_t* Br = (const bf16_t*)(ws + (r == 0 ? OFF_ATT : (r == 1 ? OFF_MLS : OFF_HYO)));
          f32x4 ag[4][2], ab[4][2]; zero_acc<2>(ag); zero_acc<2>(ab);
          gemm_mainloop<2>(A, D, Wg + (size_t)r * 1024 * 1024, D, D, m0, n0, ag, smem);
          gemm_mainloop<2>(Br, 512, Wb + (size_t)r * 1024 * 512, 512, 512, m0, n0, ab, smem);
#pragma unroll
          for (int mi = 0; mi < 4; ++mi)
#pragma unroll
            for (int ni = 0; ni < 2; ++ni)
#pragma unroll
              for (int j = 0; j < 4; ++j) y[mi][ni][j] += sigm(ag[mi][ni][j]) * ab[mi][ni][j];
        }
        gemm_epi<2>(y, m0, n0, [&](int m, int n, f32x4 v) {
          uint2 pk; pk.x = pack2(v[0], v[1]); pk.y = pack2(v[2], v[3]); *(uint2*)(Y + (size_t)m * D + n) = pk; });
      }
    }
    grid.sync();
    {
      const bf16_t* Y = (const bf16_t*)(ws + OFF_Y); const bf16_t* Wt = (const bf16_t*)(ws + OFF_WOUT);
      for (int tile = bid; tile < mtiles * 16; tile += nblk) {
        const int m0 = (tile >> 4) * 128, n0 = (tile & 15) * 64;
        f32x4 acc[4][2]; zero_acc<2>(acc);
        gemm_mainloop<2>(Y, D, Wt, D, D, m0, n0, acc, smem);
        gemm_epi<2>(acc, m0, n0, [&](int m, int n, f32x4 v) {
          const f32x4 g = *(const f32x4*)(MOD + (size_t)row_bi(m) * 6144 + 2048 + n);
          f32x4* xp = (f32x4*)(X + (size_t)m * D + n); *xp = *xp + g * v; });
      }
    }
    grid.sync();
    norm_mod_phase(lp(kp), l, lp(kp)->norm2_g + (size_t)l * D, 3072, 4096, mtiles * 128);
    grid.sync();
    {
      bf16_t* U = (bf16_t*)(ws + OFF_U); const bf16_t* Wt = (const bf16_t*)(ws + OFF_WUP);
      for (int tile = bid; tile < mtiles * 44; tile += nblk) {
        const int m0 = (tile / 44) * 128, n0 = (tile % 44) * 128;
        f32x4 acc[4][4]; zero_acc<4>(acc);
        gemm_mainloop<4>(A, D, Wt, D, D, m0, n0, acc, smem);
        gemm_epi<4>(acc, m0, n0, [&](int m, int n, f32x4 v) {
          uint2 pk; pk.x = pack2(v[0], v[1]); pk.y = pack2(v[2], v[3]); *(uint2*)(U + (size_t)m * 5632 + n) = pk; });
      }
    }
    grid.sync();
    {
      const bf16_t* U = (const bf16_t*)(ws + OFF_U); bf16_t* G = (bf16_t*)(ws + OFF_G);
      const float* cw = lp(kp)->ffn_conv_w + (size_t)l * 3 * 5632; const float* cb = lp(kp)->ffn_conv_b + (size_t)l * 5632;
      const int total = mtiles * 128 * 352;
      for (int i = bid * NTH + tid; i < total; i += nblk * NTH) {
        const int m = i / 352, c8 = (i % 352) * 8;
        const int t = m < M_LAT ? (m & 4095) : ((m - M_LAT) & 255), Lx = m < M_LAT ? L : LC;
        const bool hm = t > 0, hp = t < Lx - 1;
        float gv[2][8];
#pragma unroll
        for (int part = 0; part < 2; ++part) {
          const int c = c8 + part * DFF;
          const uint4 z4 = make_uint4(0, 0, 0, 0);
          const uint4 u0 = *(const uint4*)(U + (size_t)m * 5632 + c);
          const uint4 um = hm ? *(const uint4*)(U + (size_t)(m - 1) * 5632 + c) : z4;
          const uint4 up = hp ? *(const uint4*)(U + (size_t)(m + 1) * 5632 + c) : z4;
          const bf16_t* e0 = (const bf16_t*)&u0; const bf16_t* em = (const bf16_t*)&um; const bf16_t* ep = (const bf16_t*)&up;
#pragma unroll
          for (int e = 0; e < 8; ++e)
            gv[part][e] = cb[c + e] + cw[c + e] * bf2f(em[e]) + cw[5632 + c + e] * bf2f(e0[e]) + cw[2 * 5632 + c + e] * bf2f(ep[e]);
        }
        uint4 o;
        o.x = pack2(gv[0][0] * sigm(gv[0][0]) * gv[1][0], gv[0][1] * sigm(gv[0][1]) * gv[1][1]);
        o.y = pack2(gv[0][2] * sigm(gv[0][2]) * gv[1][2], gv[0][3] * sigm(gv[0][3]) * gv[1][3]);
        o.z = pack2(gv[0][4] * sigm(gv[0][4]) * gv[1][4], gv[0][5] * sigm(gv[0][5]) * gv[1][5]);
        o.w = pack2(gv[0][6] * sigm(gv[0][6]) * gv[1][6], gv[0][7] * sigm(gv[0][7]) * gv[1][7]);
        *(uint4*)(G + (size_t)m * DFF + c8) = o;
      }
    }
    grid.sync();
    {
      const bf16_t* G = (const bf16_t*)(ws + OFF_G); const bf16_t* Wt = (const bf16_t*)(ws + OFF_WDN);
      for (int tile = bid; tile < mtiles * 16; tile += nblk) {
        const int m0 = (tile >> 4) * 128, n0 = (tile & 15) * 64;
        f32x4 acc[4][2]; zero_acc<2>(acc);
        gemm_mainloop<2>(G, DFF, Wt, DFF, DFF, m0, n0, acc, smem);
        gemm_epi<2>(acc, m0, n0, [&](int m, int n, f32x4 v) {
          const f32x4 g = *(const f32x4*)(MOD + (size_t)row_bi(m) * 6144 + 5120 + n);
          f32x4* xp = (f32x4*)(X + (size_t)m * D + n); *xp = *xp + g * v; });
      }
    }
    grid.sync();
  }
  {
    const int lane = tid & 63, gw = bid * 4 + (tid >> 6), nw = nblk * 4;
    for (int m = gw; m < M_LAT; m += nw) {
      const float4* xr = (const float4*)(X + (size_t)m * D);
      float4 v[4]; float ss = 0.f;
#pragma unroll
      for (int i = 0; i < 4; ++i) { v[i] = xr[lane + 64 * i]; ss += v[i].x * v[i].x + v[i].y * v[i].y + v[i].z * v[i].z + v[i].w * v[i].w; }
      ss = wave_sum(ss);
      const float inv = rsqrtf(ss * (1.f / D) + EPS);
#pragma unroll
      for (int i = 0; i < 4; ++i) {
        const float4 g = ((const float4*)lp(kp)->final_g)[lane + 64 * i];
        ((float4*)(lp(kp)->out + (size_t)m * D))[lane + 64 * i] = make_float4(v[i].x * inv * g.x, v[i].y * inv * g.y, v[i].z * inv * g.z, v[i].w * inv * g.w);
      }
    }
  }
}

extern "C" void kernel_launch(void* const* d_in, const int* in_sizes, int n_in, void* d_out, int out_size, void* d_ws, size_t ws_size,
                              hipStream_t stream) {
  static int grid_blocks = 0;
  if (!grid_blocks) {
    int dev = 0, cus = 0, per_cu = 0;
    hipGetDevice(&dev);
    hipDeviceGetAttribute(&cus, hipDeviceAttributeMultiprocessorCount, dev);
    hipOccupancyMaxActiveBlocksPerMultiprocessor(&per_cu, fwd_megakernel, NTH, 0);
    if (per_cu > 2) per_cu = 2;
    grid_blocks = cus * per_cu;
  }
  if (ws_size < WS_NEED) { fprintf(stderr, "workspace too small: %zu < %zu\n", ws_size, (size_t)WS_NEED); return; }
  Params p{};
  const float** pp = (const float**)&p;
  for (int i = 0; i < 28; ++i) pp[i] = (const float*)d_in[i];
  p.out = (float*)d_out;
  p.ws = (char*)d_ws;
  void* args[] = {&p};
  hipError_t e = hipLaunchCooperativeKernel((void*)fwd_megakernel, dim3(grid_blocks), dim3(NTH), args, 0, stream);
  if (e != hipSuccess) fprintf(stderr, "cooperative launch failed: %s (grid %d)\n", hipGetErrorString(e), grid_blocks);
}
```

```cpp
#include <hip/hip_runtime.h>
#include <hip/hip_cooperative_groups.h>
#include <cstdio>
namespace cg = cooperative_groups;

#define DEV __device__ __forceinline__
typedef unsigned short bf16_t;
typedef short bf16x8 __attribute__((ext_vector_type(8)));
typedef float f32x4 __attribute__((ext_vector_type(4)));

constexpr int D = 1024, L = 4096, LC = 256, M_LAT = 16384, M_CTX = 1024, M_ALL = 17408;
constexpr int N_IN = 7440, N_INP = 4480, DFF = 2816;
constexpr int NTH = 256;
constexpr int SMEM_BYTES = 77824;
constexpr float EPS = 1e-6f;

constexpr size_t al256(size_t x) { return (x + 255) & ~(size_t)255; }
constexpr size_t OFF_X = 0;
constexpr size_t OFF_A = OFF_X + al256((size_t)M_ALL * D * 4);
constexpr size_t OFF_MOD = OFF_A + al256((size_t)M_ALL * D * 2);
constexpr size_t OFF_TW = OFF_MOD + al256((size_t)4 * 5 * 6144 * 4);
constexpr size_t OFF_ROPE = OFF_TW + al256((size_t)4096 * 8);
constexpr size_t OFF_HID = OFF_ROPE + al256((size_t)4096 * 64 * 4);
constexpr size_t OFF_WIN = OFF_HID + al256((size_t)4 * 4352 * 64 * 4);
constexpr size_t OFF_WG = OFF_WIN + al256((size_t)N_INP * 1024 * 2);
constexpr size_t OFF_WBR = OFF_WG + al256((size_t)3072 * 1024 * 2);
constexpr size_t OFF_WOUT = OFF_WBR + al256((size_t)3 * 1024 * 512 * 2);
constexpr size_t OFF_WUP = OFF_WOUT + al256((size_t)1024 * 1024 * 2);
constexpr size_t OFF_WDN = OFF_WUP + al256((size_t)5632 * 1024 * 2);
constexpr size_t OFF_FILT = OFF_WDN + al256((size_t)1024 * 2816 * 2);
constexpr size_t OFF_FILTC = OFF_FILT + al256((size_t)2048 * 4096 * 4);
constexpr size_t OFF_STATS = OFF_FILTC + al256((size_t)2048 * 256 * 4);
constexpr size_t OFF_BIG = OFF_STATS + al256((size_t)32 * 34 * 4 * 4);
constexpr size_t OFF_QKV = OFF_BIG;
constexpr size_t OFF_ML = OFF_QKV + al256((size_t)M_ALL * 768 * 2);
constexpr size_t OFF_MLG = OFF_ML + al256((size_t)M_ALL * 2048 * 2);
constexpr size_t OFF_HYT = OFF_MLG + al256((size_t)M_ALL * 16 * 4);
constexpr size_t OFF_HYTC = OFF_HYT + al256((size_t)M_LAT * 1536 * 2);
constexpr size_t OFF_ATT = OFF_HYTC + al256((size_t)M_CTX * 1536 * 2);
constexpr size_t OFF_MLS = OFF_ATT + al256((size_t)M_ALL * 512 * 2);
constexpr size_t OFF_HYO = OFF_MLS + al256((size_t)M_ALL * 512 * 2);
constexpr size_t OFF_STATES = OFF_HYO + al256((size_t)M_ALL * 512 * 2);
constexpr size_t OFF_Y = OFF_STATES;
constexpr size_t END_MIX = OFF_STATES + al256((size_t)32 * 34 * 16512 * 4);
constexpr size_t OFF_U = OFF_BIG;
constexpr size_t OFF_G = OFF_U + al256((size_t)M_ALL * 5632 * 2);
constexpr size_t END_FFN = OFF_G + al256((size_t)M_ALL * 2816 * 2);
constexpr size_t WS_NEED = END_MIX > END_FFN ? END_MIX : END_FFN;

struct Params {
  const float *x, *c, *ctx, *c_ctx, *ada_w, *ada_b, *norm1_g, *norm2_g, *w_in, *att_sink, *ml_gate_b, *ml_norm_g,
      *hy_short_w, *hy_short_b, *hy_w1, *hy_b1, *hy_w2, *hy_b2, *hy_w3, *hy_freq, *hy_skip, *w_branch, *w_out, *w_up,
      *ffn_conv_w, *ffn_conv_b, *w_down, *final_g;
  float* out;
  char* ws;
};

typedef const __attribute__((address_space(4))) Params* KP;
DEV KP lp(KP q) { asm volatile("" : "+s"(q)); return q; }
DEV int otid() { int t = threadIdx.x; asm volatile("" : "+v"(t)); return t; }
DEV bf16_t f2bf(float f) { unsigned u = __float_as_uint(f); u += 0x7fffu + ((u >> 16) & 1u); return (bf16_t)(u >> 16); }
DEV float bf2f(bf16_t h) { return __uint_as_float(((unsigned)h) << 16); }
DEV unsigned pack2(float a, float b) { return (unsigned)f2bf(a) | ((unsigned)f2bf(b) << 16); }
DEV float sigm(float x) { return 1.f / (1.f + __expf(-x)); }
DEV float logsigm(float x) { return fminf(x, 0.f) - log1pf(expf(-fabsf(x))); }
DEV int row_bi(int m) { return m < M_LAT ? (m >> 12) : 4; }
DEV float wave_sum(float v) {
#pragma unroll
  for (int o = 32; o >= 1; o >>= 1) v += __shfl_xor(v, o);
  return v;
}
DEV float quad_sum(float v) { v += __shfl_xor(v, 16); v += __shfl_xor(v, 32); return v; }
DEV float quad_max(float v) { v = fmaxf(v, __shfl_xor(v, 16)); v = fmaxf(v, __shfl_xor(v, 32)); return v; }

template <int NT, int KS>
DEV void wave_mma(const bf16_t* pa, const bf16_t* pb, int ldb, f32x4 (&acc)[NT]) {
#pragma unroll
  for (int ks = 0; ks < KS; ++ks) {
    __builtin_amdgcn_sched_barrier(0);
    bf16x8 a = *(const bf16x8*)(pa + ks * 32);
#pragma unroll
    for (int ni = 0; ni < NT; ++ni) {
      bf16x8 b = *(const bf16x8*)(pb + ni * 16 * ldb + ks * 32);
      acc[ni] = __builtin_amdgcn_mfma_f32_16x16x32_bf16(b, a, acc[ni], 0, 0, 0);
    }
  }
}

constexpr int LDSS = 72;
template <int NI>
DEV void gemm_mainloop(const bf16_t* __restrict__ A, int lda, const bf16_t* __restrict__ Bt, int ldb, int K, int m0, int n0,
                       f32x4 (&acc)[4][NI], char* smem) {
  constexpr int TN = NI * 32;
  bf16_t* sA = (bf16_t*)smem;
  bf16_t* sB = sA + 2 * 128 * LDSS;
  const int tid = otid(), lane = tid & 63, wid = tid >> 6, wm = wid >> 1, wn = wid & 1, fr = lane & 15, fq = lane >> 4;
  uint4 ra[4], rb[NI];
  const bf16_t* Ap = A + (size_t)m0 * lda;
  const bf16_t* Bp = Bt + (size_t)n0 * ldb;
  const int lrow = tid >> 3, lkc = (tid & 7) * 8;
  __syncthreads();
#pragma unroll
  for (int i = 0; i < 4; ++i) ra[i] = *(const uint4*)(Ap + (size_t)(lrow + 32 * i) * lda + lkc);
#pragma unroll
  for (int i = 0; i < NI; ++i) rb[i] = *(const uint4*)(Bp + (size_t)(lrow + 32 * i) * ldb + lkc);
#pragma unroll
  for (int i = 0; i < 4; ++i) *(uint4*)(sA + (lrow + 32 * i) * LDSS + lkc) = ra[i];
#pragma unroll
  for (int i = 0; i < NI; ++i) *(uint4*)(sB + (lrow + 32 * i) * LDSS + lkc) = rb[i];
  __syncthreads();
  const int nk = K >> 6;
  for (int kt = 0; kt < nk; ++kt) {
    const int buf = kt & 1;
    if (kt + 1 < nk) {
      const int k0 = (kt + 1) << 6;
#pragma unroll
      for (int i = 0; i < 4; ++i) ra[i] = *(const uint4*)(Ap + (size_t)(lrow + 32 * i) * lda + k0 + lkc);
#pragma unroll
      for (int i = 0; i < NI; ++i) rb[i] = *(const uint4*)(Bp + (size_t)(lrow + 32 * i) * ldb + k0 + lkc);
    }
    const bf16_t* ab = sA + buf * 128 * LDSS + (wm * 64 + fr) * LDSS + fq * 8;
    const bf16_t* bb = sB + buf * TN * LDSS + (wn * (TN / 2) + fr) * LDSS + fq * 8;
#pragma unroll
    for (int ks = 0; ks < 2; ++ks) {
      bf16x8 af[4], bfr[NI];
#pragma unroll
      for (int mi = 0; mi < 4; ++mi) af[mi] = *(const bf16x8*)(ab + mi * 16 * LDSS + ks * 32);
#pragma unroll
      for (int ni = 0; ni < NI; ++ni) bfr[ni] = *(const bf16x8*)(bb + ni * 16 * LDSS + ks * 32);
#pragma unroll
      for (int mi = 0; mi < 4; ++mi)
#pragma unroll
        for (int ni = 0; ni < NI; ++ni) acc[mi][ni] = __builtin_amdgcn_mfma_f32_16x16x32_bf16(bfr[ni], af[mi], acc[mi][ni], 0, 0, 0);
    }
    if (kt + 1 < nk) {
      bf16_t* dA = sA + (buf ^ 1) * 128 * LDSS;
      bf16_t* dB = sB + (buf ^ 1) * TN * LDSS;
#pragma unroll
      for (int i = 0; i < 4; ++i) *(uint4*)(dA + (lrow + 32 * i) * LDSS + lkc) = ra[i];
#pragma unroll
      for (int i = 0; i < NI; ++i) *(uint4*)(dB + (lrow + 32 * i) * LDSS + lkc) = rb[i];
    }
    __syncthreads();
  }
}
template <int NI>
DEV void zero_acc(f32x4 (&acc)[4][NI]) {
#pragma unroll
  for (int mi = 0; mi < 4; ++mi)
#pragma unroll
    for (int ni = 0; ni < NI; ++ni) acc[mi][ni] = (f32x4){0.f, 0.f, 0.f, 0.f};
}
template <int NI, class F>
DEV void gemm_epi(f32x4 (&acc)[4][NI], int m0, int n0, F f) {
  const int tid = otid(), lane = tid & 63, wid = tid >> 6, wm = wid >> 1, wn = wid & 1, fr = lane & 15, fq = lane >> 4;
#pragma unroll
  for (int mi = 0; mi < 4; ++mi)
#pragma unroll
    for (int ni = 0; ni < NI; ++ni) f(m0 + wm * 64 + mi * 16 + fr, n0 + wn * (NI * 16) + ni * 16 + fq * 4, acc[mi][ni]);
}

DEV int colmap(int mode, int n) {
  if (mode == 0) return n;
  if (mode == 2) return n + 4368;
  if (n < 2816) return n;
  if (n < 4352) return n + 16;
  if (n < 4368) return n - 4352 + 2816;
  return -1;
}
DEV void cvt_job(const float* __restrict__ src, int ld, int K, int Npad, bf16_t* __restrict__ dst, int mode, char* smem) {
  float* t = (float*)smem;
  const int tid = otid(), ntn = Npad >> 6, ntiles = (K >> 6) * ntn;
  for (int tile = blockIdx.x; tile < ntiles; tile += gridDim.x) {
    const int k0 = (tile / ntn) << 6, n0 = (tile % ntn) << 6;
    __syncthreads();
    const int col = tid & 63, sc = colmap(mode, n0 + col);
#pragma unroll 4
    for (int r = 0; r < 16; ++r) {
      const int row = r * 4 + (tid >> 6);
      t[row * 65 + col] = sc >= 0 ? src[(size_t)(k0 + row) * ld + sc] : 0.f;
    }
    __syncthreads();
#pragma unroll
    for (int s = 0; s < 2; ++s) {
      const int slot = tid + 256 * s, n = slot >> 3, kg = slot & 7;
      uint4 v;
      v.x = pack2(t[(kg * 8 + 0) * 65 + n], t[(kg * 8 + 1) * 65 + n]);
      v.y = pack2(t[(kg * 8 + 2) * 65 + n], t[(kg * 8 + 3) * 65 + n]);
      v.z = pack2(t[(kg * 8 + 4) * 65 + n], t[(kg * 8 + 5) * 65 + n]);
      v.w = pack2(t[(kg * 8 + 6) * 65 + n], t[(kg * 8 + 7) * 65 + n]);
      *(uint4*)(dst + (size_t)(n0 + n) * K + k0 + kg * 8) = v;
    }
  }
}

DEV void phase0(KP p, char* smem) {
  const int tid = otid(), gtid = blockIdx.x * NTH + tid, gsz = gridDim.x * NTH;
  float* X = (float*)(p->ws + OFF_X);
  for (int i = gtid; i < M_ALL * D / 4; i += gsz) {
    float4 v = i < M_LAT * D / 4 ? ((const float4*)p->x)[i] : ((const float4*)p->ctx)[i - M_LAT * D / 4];
    ((float4*)X)[i] = v;
  }
  float2* TW = (float2*)(p->ws + OFF_TW);
  for (int i = gtid; i < 4096; i += gsz) { float s, c; sincospif((float)i / 4096.f, &s, &c); TW[i] = make_float2(c, -s); }
  float* ROPE = (float*)(p->ws + OFF_ROPE);
  for (int i = gtid; i < 4096 * 32; i += gsz) {
    const int pos = i >> 5, f = i & 31;
    const float inv = powf(10000.f, -(float)(f & 15) / 16.f);
    const float ang = (f < 16 ? (float)(pos >> 6) : (float)(pos & 63)) * inv;
    ROPE[pos * 64 + f] = cosf(ang); ROPE[pos * 64 + 32 + f] = sinf(ang);
  }
  {
    float* HID = (float*)(p->ws + OFF_HID);
    float* sz = (float*)smem;
    float* sh = sz + 4 * 36;
    const int sub = tid >> 6, j = tid & 63;
    for (int it = blockIdx.x; it < 4 * 4352 / 4; it += gridDim.x) {
      const int item = it * 4 + sub, l = item / 4352, tt = item % 4352;
      const bool isc = tt >= 4096; const int t = isc ? tt - 4096 : tt; const int Lx = isc ? LC : L;
      __syncthreads();
      if (j < 33) {
        float z;
        if (j == 0) z = (float)t / (float)(Lx - 1);
        else {
          const int bidx = (j - 1) & 15;
          const float band = 1e-4f + (15.f - 1e-4f) * (float)bidx / 15.f;
          const float w = 2.0f * 3.14159265358979323846f * (float)t / (float)Lx;
          z = j <= 16 ? cosf(w * band) : -sinf(w * band);
        }
        sz[sub * 36 + j] = z;
      }
      __syncthreads();
      const float* w1 = p->hy_w1 + (size_t)l * 33 * 64; const float* w2 = p->hy_w2 + (size_t)l * 64 * 64;
      float a = p->hy_b1[l * 64 + j];
      for (int k = 0; k < 33; ++k) a += sz[sub * 36 + k] * w1[k * 64 + j];
      sh[sub * 64 + j] = sinf(p->hy_freq[l * 128 + j] * a);
      __syncthreads();
      float b = p->hy_b2[l * 64 + j];
      for (int k = 0; k < 64; ++k) b += sh[sub * 64 + k] * w2[k * 64 + j];
      HID[((size_t)l * 4352 + tt) * 64 + j] = sinf(p->hy_freq[l * 128 + 64 + j] * b);
    }
  }
  if (blockIdx.x < 384) {
    float* ssc = (float*)smem;
    float* red = ssc + 5 * 1024;
    __syncthreads();
    for (int i = tid; i < 5 * 1024; i += NTH) { const float v = i < 4096 ? p->c[i] : p->c_ctx[i - 4096]; ssc[i] = v * sigm(v); }
    __syncthreads();
    float* MOD = (float*)(p->ws + OFF_MOD);
    for (int it = blockIdx.x; it < 384; it += gridDim.x) {
      const int l = it / 96, cb = it % 96, col = cb * 64 + (tid & 63), kg = tid >> 6;
      const float* w = p->ada_w + (size_t)l * 1024 * 6144 + col;
      float a0 = 0, a1 = 0, a2 = 0, a3 = 0, a4 = 0;
#pragma unroll 8
      for (int k = kg * 256; k < kg * 256 + 256; ++k) {
        const float wv = w[(size_t)k * 6144];
        a0 += ssc[k] * wv; a1 += ssc[1024 + k] * wv; a2 += ssc[2048 + k] * wv; a3 += ssc[3072 + k] * wv; a4 += ssc[4096 + k] * wv;
      }
      __syncthreads();
      red[(kg * 5 + 0) * 64 + (tid & 63)] = a0; red[(kg * 5 + 1) * 64 + (tid & 63)] = a1; red[(kg * 5 + 2) * 64 + (tid & 63)] = a2;
      red[(kg * 5 + 3) * 64 + (tid & 63)] = a3; red[(kg * 5 + 4) * 64 + (tid & 63)] = a4;
      __syncthreads();
      for (int o = tid; o < 320; o += NTH) {
        const int bi = o >> 6, cc = o & 63;
        const float s = red[(0 * 5 + bi) * 64 + cc] + red[(1 * 5 + bi) * 64 + cc] + red[(2 * 5 + bi) * 64 + cc] + red[(3 * 5 + bi) * 64 + cc];
        MOD[((size_t)l * 5 + bi) * 6144 + cb * 64 + cc] = s + p->ada_b[l * 6144 + cb * 64 + cc];
      }
    }
  }
}

DEV void norm_mod_phase(KP p, int l, const float* gain, int sh_off, int sc_off, int nrows) {
  const float* X = (const float*)(p->ws + OFF_X);
  bf16_t* A = (bf16_t*)(p->ws + OFF_A);
  const float* MOD = (const float*)(p->ws + OFF_MOD) + (size_t)l * 5 * 6144;
  const int tid_ = otid(); const int lane = tid_ & 63, gw = blockIdx.x * 4 + (tid_ >> 6), nw = gridDim.x * 4;
  for (int m = gw; m < nrows; m += nw) {
    const float4* xr = (const float4*)(X + (size_t)m * D);
    float4 v[4]; float ss = 0.f;
#pragma unroll
    for (int i = 0; i < 4; ++i) { v[i] = xr[lane + 64 * i]; ss += v[i].x * v[i].x + v[i].y * v[i].y + v[i].z * v[i].z + v[i].w * v[i].w; }
    ss = wave_sum(ss);
    const float inv = rsqrtf(ss * (1.f / D) + EPS);
    const float* mo = MOD + (size_t)row_bi(m) * 6144;
#pragma unroll
    for (int i = 0; i < 4; ++i) {
      const int n = (lane + 64 * i) * 4;
      const float4 g = *(const float4*)(gain + n), sh = *(const float4*)(mo + sh_off + n), sc = *(const float4*)(mo + sc_off + n);
      uint2 o;
      o.x = pack2(v[i].x * inv * g.x * (1.f + sc.x) + sh.x, v[i].y * inv * g.y * (1.f + sc.y) + sh.y);
      o.y = pack2(v[i].z * inv * g.z * (1.f + sc.z) + sh.z, v[i].w * inv * g.w * (1.f + sc.w) + sh.w);
      *(uint2*)(A + (size_t)m * D + n) = o;
    }
  }
}

template <int NIT>
DEV void filt_item(KP p, int l, int q, bool isc, char* smem) {
  constexpr int Lx = NIT * 256;
  const int tid = otid(), lane = tid & 63, wid = tid >> 6;
  float4* sW = (float4*)smem;
  float* sred = (float*)(smem + 1024);
  __syncthreads();
  if (tid < 64) { const float* w3 = p->hy_w3 + ((size_t)l * 64 + tid) * 2048 + q * 4; sW[tid] = *(const float4*)w3; }
  __syncthreads();
  const float* HID = (const float*)(p->ws + OFF_HID) + ((size_t)l * 4352 + (isc ? 4096 : 0)) * 64;
  float r[NIT][4]; float s0 = 0, s1 = 0, s2 = 0, s3 = 0;
  const int c0 = (q * 4) & 511;
  const float a0 = logf(0.01f) / 1.5f, a1 = logf(0.01f) / 0.3f;
  float dl[4];
#pragma unroll
  for (int e = 0; e < 4; ++e) dl[e] = fabsf(a0 + (a1 - a0) * (float)(c0 + e) / 511.f);
#pragma unroll
  for (int i = 0; i < NIT; ++i) {
    const int t = tid + 256 * i;
    const float4* hr = (const float4*)(HID + (size_t)t * 64);
    float x0 = 0, x1 = 0, x2 = 0, x3 = 0;
#pragma unroll 4
    for (int j4 = 0; j4 < 16; ++j4) {
      const float4 h = hr[j4];
      float4 w;
      w = sW[j4 * 4 + 0]; x0 += h.x * w.x; x1 += h.x * w.y; x2 += h.x * w.z; x3 += h.x * w.w;
      w = sW[j4 * 4 + 1]; x0 += h.y * w.x; x1 += h.y * w.y; x2 += h.y * w.z; x3 += h.y * w.w;
      w = sW[j4 * 4 + 2]; x0 += h.z * w.x; x1 += h.z * w.y; x2 += h.z * w.z; x3 += h.z * w.w;
      w = sW[j4 * 4 + 3]; x0 += h.w * w.x; x1 += h.w * w.y; x2 += h.w * w.z; x3 += h.w * w.w;
    }
    const float tn = (float)t / (float)(Lx - 1);
    x0 *= expf(-tn * dl[0]); x1 *= expf(-tn * dl[1]); x2 *= expf(-tn * dl[2]); x3 *= expf(-tn * dl[3]);
    r[i][0] = x0; r[i][1] = x1; r[i][2] = x2; r[i][3] = x3;
    s0 += fabsf(x0); s1 += fabsf(x1); s2 += fabsf(x2); s3 += fabsf(x3);
  }
  s0 = wave_sum(s0); s1 = wave_sum(s1); s2 = wave_sum(s2); s3 = wave_sum(s3);
  if (lane == 0) { sred[wid * 4 + 0] = s0; sred[wid * 4 + 1] = s1; sred[wid * 4 + 2] = s2; sred[wid * 4 + 3] = s3; }
  __syncthreads();
  float inv[4];
#pragma unroll
  for (int e = 0; e < 4; ++e) inv[e] = 1.f / (sred[e] + sred[4 + e] + sred[8 + e] + sred[12 + e]);
  float* F = (float*)(p->ws + (isc ? OFF_FILTC : OFF_FILT));
#pragma unroll
  for (int i = 0; i < NIT; ++i) {
    const int t = tid + 256 * i;
#pragma unroll
    for (int e = 0; e < 4; ++e) F[(size_t)(q * 4 + e) * Lx + t] = r[i][e] * inv[e];
  }
}

template <int LOGN>
DEV void fft_dif(float2* z, const float2* __restrict__ TW) {
  constexpr int N = 1 << LOGN;
  for (int lh = LOGN - 1; lh >= 0; --lh) {
    const int h = 1 << lh;
    for (int j = otid(); j < N / 2; j += NTH) {
      const int pos = j & (h - 1), i0 = ((j >> lh) << (lh + 1)) + pos, i1 = i0 + h;
      const float2 w = TW[pos << (12 - lh)];
      const float2 a = z[i0], b = z[i1];
      z[i0] = make_float2(a.x + b.x, a.y + b.y);
      const float dx = a.x - b.x, dy = a.y - b.y;
      z[i1] = make_float2(dx * w.x - dy * w.y, dx * w.y + dy * w.x);
    }
    __syncthreads();
  }
}
template <int LOGN>
DEV void fft_dit_inv(float2* z, const float2* __restrict__ TW) {
  constexpr int N = 1 << LOGN;
  for (int lh = 0; lh < LOGN; ++lh) {
    const int h = 1 << lh;
    for (int j = otid(); j < N / 2; j += NTH) {
      const int pos = j & (h - 1), i0 = ((j >> lh) << (lh + 1)) + pos, i1 = i0 + h;
      const float2 w = TW[pos << (12 - lh)];
      const float2 a = z[i0], b0 = z[i1];
      const float bx = b0.x * w.x + b0.y * w.y, by = b0.y * w.x - b0.x * w.y;
      z[i0] = make_float2(a.x + bx, a.y + by);
      z[i1] = make_float2(a.x - bx, a.y - by);
    }
    __syncthreads();
  }
}
DEV float conv3(const bf16_t* __restrict__ row, int t, int Lx, float w0, float w1, float w2, float b) {
  const float xm = t > 0 ? bf2f(row[t - 1]) : 0.f, x0 = bf2f(row[t]), xp = t < Lx - 1 ? bf2f(row[t + 1]) : 0.f;
  return b + w0 * xm + w1 * x0 + w2 * xp;
}
template <int LOGN>
DEV void hyena_item(KP p, int l, int c, int pair, bool isc, char* smem) {
  constexpr int N = 1 << LOGN, Lx = N / 2, NPT = N / 256, LPT = Lx / 256;
  const int tid = otid();
  float2* z = (float2*)smem;
  const float2* TW = (const float2*)(p->ws + OFF_TW);
  const float* F = (const float*)(p->ws + (isc ? OFF_FILTC : OFF_FILT));
  const bf16_t* H = (const bf16_t*)(p->ws + (isc ? OFF_HYTC : OFF_HYT));
  bf16_t* HYO = (bf16_t*)(p->ws + OFF_HYO);
  const float* sw = p->hy_short_w + (size_t)l * 3 * 1536; const float* sb = p->hy_short_b + (size_t)l * 1536;
  const int b0 = 2 * pair, b1 = 2 * pair + 1;
  float2 G[NPT]; float2 z1[LPT];
  __syncthreads();
#pragma unroll 1
  for (int o = 0; o < 2; ++o) {
    {
      const float* hf = F + (size_t)((o * 2 + 0) * 512 + c) * Lx;
      const float* hb = F + (size_t)((o * 2 + 1) * 512 + c) * Lx;
      const float skip = p->hy_skip[(size_t)l * 1024 + o * 512 + c];
#pragma unroll 2
      for (int n = tid; n < N; n += 256) {
        float v;
        if (n < Lx) v = hf[n] + (n == 0 ? hb[0] + skip : 0.f);
        else if (n == Lx) v = 0.f;
        else v = hb[N - n];
        z[n] = make_float2(v, 0.f);
      }
    }
    __syncthreads();
    fft_dif<LOGN>(z, TW);
#pragma unroll
    for (int i = 0; i < NPT; ++i) G[i] = z[tid + 256 * i];
    __syncthreads();
    if (o == 0) {
      const int cc = 1024 + c;
      const float w0 = sw[cc], w1 = sw[1536 + cc], w2 = sw[3072 + cc], bb = sb[cc];
      const bf16_t* r0 = H + ((size_t)b0 * 1536 + cc) * Lx; const bf16_t* r1 = H + ((size_t)b1 * 1536 + cc) * Lx;
#pragma unroll 2
      for (int t = tid; t < Lx; t += 256) {
        z[t] = make_float2(conv3(r0, t, Lx, w0, w1, w2, bb), conv3(r1, t, Lx, w0, w1, w2, bb));
        z[t + Lx] = make_float2(0.f, 0.f);
      }
    } else {
#pragma unroll
      for (int i = 0; i < LPT; ++i) { const int t = tid + 256 * i; z[t] = z1[i]; z[t + Lx] = make_float2(0.f, 0.f); }
    }
    __syncthreads();
    fft_dif<LOGN>(z, TW);
#pragma unroll
    for (int i = 0; i < NPT; ++i) {
      const int n = tid + 256 * i; const float2 a = z[n], g = G[i];
      z[n] = make_float2(a.x * g.x - a.y * g.y, a.x * g.y + a.y * g.x);
    }
    __syncthreads();
    fft_dit_inv<LOGN>(z, TW);
    {
      const int cc = o * 512 + c;
      const float w0 = sw[cc], w1 = sw[1536 + cc], w2 = sw[3072 + cc], bb = sb[cc];
      const bf16_t* r0 = H + ((size_t)b0 * 1536 + cc) * Lx; const bf16_t* r1 = H + ((size_t)b1 * 1536 + cc) * Lx;
#pragma unroll 2
      for (int t = tid; t < Lx; t += 256) {
        const float2 y = z[t];
        const float o0 = conv3(r0, t, Lx, w0, w1, w2, bb) * y.x * (1.f / N), o1 = conv3(r1, t, Lx, w0, w1, w2, bb) * y.y * (1.f / N);
        if (o == 0) z[t] = make_float2(o0, o1);
        else {
          const size_t ra = isc ? (size_t)(M_LAT + b0 * LC + t) : (size_t)(b0 * L + t);
          const size_t rb = isc ? (size_t)(M_LAT + b1 * LC + t) : (size_t)(b1 * L + t);
          HYO[ra * 512 + c] = f2bf(o0); HYO[rb * 512 + c] = f2bf(o1);
        }
      }
      if (o == 0) {
#pragma unroll
        for (int i = 0; i < LPT; ++i) z1[i] = z[tid + 256 * i];
      }
    }
    __syncthreads();
  }
}

constexpr int AQ_LD = 72, AP_LD = 136;
DEV void attn_item(KP p, int l, int b, int qt, int qh, bool isc, char* smem) {
  const int tid = otid(), lane = tid & 63, w = tid >> 6, fr = lane & 15, fq = lane >> 4;
  const bf16_t* QKV = (const bf16_t*)(p->ws + OFF_QKV);
  const float* ROPE = (const float*)(p->ws + OFF_ROPE);
  bf16_t* ATT = (bf16_t*)(p->ws + OFF_ATT);
  bf16_t* sQ = (bf16_t*)smem;
  bf16_t* sVt = sQ + 128 * AQ_LD;
  bf16_t* sP = sVt + 64 * AP_LD;
  bf16_t* sK = sP;
  const int kv = qh >> 2;
  const int qrow0 = isc ? (M_LAT + b * LC + qt * 128) : (b * L + qt * 128);
  const int r2 = tid >> 1, hh = tid & 1;
  __syncthreads();
  {
    const bf16_t* src = QKV + (size_t)(qrow0 + r2) * 768 + qh * 64 + hh * 16;
    uint4 lo0 = *(const uint4*)(src), lo1 = *(const uint4*)(src + 8), hi0 = *(const uint4*)(src + 32), hi1 = *(const uint4*)(src + 40);
    bf16_t* d = sQ + r2 * AQ_LD + hh * 16;
    if (isc) { *(uint4*)d = lo0; *(uint4*)(d + 8) = lo1; *(uint4*)(d + 32) = hi0; *(uint4*)(d + 40) = hi1; }
    else {
      const float* rp = ROPE + (size_t)(qt * 128 + r2) * 64 + hh * 16;
      const bf16_t* a = (const bf16_t*)&lo0; const bf16_t* a2 = (const bf16_t*)&lo1; const bf16_t* c = (const bf16_t*)&hi0; const bf16_t* c2 = (const bf16_t*)&hi1;
#pragma unroll
      for (int i = 0; i < 16; ++i) {
        const float t1 = bf2f(i < 8 ? a[i] : a2[i - 8]), t2 = bf2f(i < 8 ? c[i] : c2[i - 8]);
        const float cs = rp[i], sn = rp[32 + i];
        d[i] = f2bf(t1 * cs - t2 * sn); d[32 + i] = f2bf(t2 * cs + t1 * sn);
      }
    }
  }
  float mrun[2], lrun[2];
  const float sink = p->att_sink[l * 8 + qh];
  mrun[0] = mrun[1] = sink; lrun[0] = lrun[1] = 1.f;
  f32x4 O[2][4];
#pragma unroll
  for (int mi = 0; mi < 2; ++mi)
#pragma unroll
    for (int ni = 0; ni < 4; ++ni) O[mi][ni] = (f32x4){0.f, 0.f, 0.f, 0.f};
  const int ntile = isc ? 2 : 5;
#pragma unroll 1
  for (int kt = 0; kt < ntile; ++kt) {
    int krow0, kpos0 = 0, mode = 0;
    bool rope = false;
    if (kt < 2) krow0 = M_LAT + b * LC + kt * 128;
    else {
      const int kb = qt - 1 + (kt - 2);
      if (kb < 0 || kb >= 32) continue;
      krow0 = b * L + kb * 128; kpos0 = kb * 128; rope = true; mode = kt == 2 ? 1 : (kt == 4 ? 2 : 0);
    }
    __syncthreads();
    {
      const bf16_t* src = QKV + (size_t)(krow0 + r2) * 768 + 512 + kv * 64 + hh * 16;
      uint4 lo0 = *(const uint4*)(src), lo1 = *(const uint4*)(src + 8), hi0 = *(const uint4*)(src + 32), hi1 = *(const uint4*)(src + 40);
      bf16_t* d = sK + r2 * AQ_LD + hh * 16;
      if (!rope) { *(uint4*)d = lo0; *(uint4*)(d + 8) = lo1; *(uint4*)(d + 32) = hi0; *(uint4*)(d + 40) = hi1; }
      else {
        const float* rp = ROPE + (size_t)(kpos0 + r2) * 64 + hh * 16;
        const bf16_t* a = (const bf16_t*)&lo0; const bf16_t* a2 = (const bf16_t*)&lo1; const bf16_t* c = (const bf16_t*)&hi0; const bf16_t* c2 = (const bf16_t*)&hi1;
#pragma unroll
        for (int i = 0; i < 16; ++i) {
          const float t1 = bf2f(i < 8 ? a[i] : a2[i - 8]), t2 = bf2f(i < 8 ? c[i] : c2[i - 8]);
          const float cs = rp[i], sn = rp[32 + i];
          d[i] = f2bf(t1 * cs - t2 * sn); d[32 + i] = f2bf(t2 * cs + t1 * sn);
        }
      }
      const bf16_t* vs = QKV + (size_t)(krow0 + r2) * 768 + 640 + kv * 64 + hh * 32;
      uint4 v4[4];
#pragma unroll
      for (int i = 0; i < 4; ++i) v4[i] = *(const uint4*)(vs + 8 * i);
      const bf16_t* ve = (const bf16_t*)v4;
#pragma unroll
      for (int i = 0; i < 32; ++i) sVt[(hh * 32 + i) * AP_LD + r2] = ve[i];
    }
    __syncthreads();
    f32x4 S[2][8];
#pragma unroll
    for (int mi = 0; mi < 2; ++mi) {
#pragma unroll
      for (int ni = 0; ni < 8; ++ni) S[mi][ni] = (f32x4){0.f, 0.f, 0.f, 0.f};
      wave_mma<8, 2>(sQ + (w * 32 + mi * 16 + fr) * AQ_LD + fq * 8, sK + fr * AQ_LD + fq * 8, AQ_LD, S[mi]);
    }
    __syncthreads();
#pragma unroll
    for (int mi = 0; mi < 2; ++mi) {
      const int tau = w * 32 + mi * 16 + fr;
      float mx = -INFINITY;
#pragma unroll
      for (int ni = 0; ni < 8; ++ni)
#pragma unroll
        for (int j = 0; j < 4; ++j) {
          const int s = ni * 16 + fq * 4 + j;
          float v = S[mi][ni][j] * 0.125f;
          if ((mode == 1 && s < tau) || (mode == 2 && s > tau)) v = -INFINITY;
          S[mi][ni][j] = v; mx = fmaxf(mx, v);
        }
      mx = quad_max(mx);
      const float mnew = fmaxf(mrun[mi], mx), alpha = __expf(mrun[mi] - mnew);
      float rs = 0.f;
#pragma unroll
      for (int ni = 0; ni < 8; ++ni) {
        const float p0 = __expf(S[mi][ni][0] - mnew), p1 = __expf(S[mi][ni][1] - mnew), p2 = __expf(S[mi][ni][2] - mnew), p3 = __expf(S[mi][ni][3] - mnew);
        rs += p0 + p1 + p2 + p3;
        uint2 pk; pk.x = pack2(p0, p1); pk.y = pack2(p2, p3);
        *(uint2*)(sP + tau * AP_LD + ni * 16 + fq * 4) = pk;
      }
      rs = quad_sum(rs);
      lrun[mi] = lrun[mi] * alpha + rs; mrun[mi] = mnew;
#pragma unroll
      for (int ni = 0; ni < 4; ++ni) O[mi][ni] *= alpha;
    }
    __syncthreads();
#pragma unroll
    for (int mi = 0; mi < 2; ++mi) wave_mma<4, 4>(sP + (w * 32 + mi * 16 + fr) * AP_LD + fq * 8, sVt + fr * AP_LD + fq * 8, AP_LD, O[mi]);
  }
#pragma unroll
  for (int mi = 0; mi < 2; ++mi) {
    const float il = 1.f / lrun[mi];
    const size_t row = (size_t)(qrow0 + w * 32 + mi * 16 + fr);
#pragma unroll
    for (int ni = 0; ni < 4; ++ni) {
      uint2 pk; pk.x = pack2(O[mi][ni][0] * il, O[mi][ni][1] * il); pk.y = pack2(O[mi][ni][2] * il, O[mi][ni][3] * il);
      *(uint2*)(ATT + row * 512 + qh * 64 + ni * 16 + fq * 4) = pk;
    }
  }
}

constexpr int ML_LD = 136;
constexpr float ML_SCALE = 0.08838834764831845f;
DEV int chunk_row0(int b, int cpos) { return cpos < 2 ? (M_LAT + b * LC + cpos * 128) : (b * L + (cpos - 2) * 128); }
DEV int scan_idx(int cpos, int dir) { return dir == 0 ? cpos : (cpos < 2 ? 1 - cpos : 35 - cpos); }
DEV void mlstm_prep(KP p, int l, int row0, int h, float* sb, float* sib, float* spm) {
  const int tid = otid();
  const float* MLG = (const float*)(p->ws + OFF_MLG);
  {
    const int dir = tid >> 7, s = tid & 127;
    const float gi = MLG[(size_t)(row0 + s) * 16 + dir * 8 + h] + p->ml_gate_b[l * 16 + dir * 8 + h];
    const float gf = MLG[(size_t)(row0 + s) * 16 + dir * 8 + 4 + h] + p->ml_gate_b[l * 16 + dir * 8 + 4 + h];
    sb[tid] = logsigm(gf); sib[tid] = gi;
  }
  __syncthreads();
  if (tid == 0) {
    float run = 0.f, mx = -INFINITY;
    for (int s = 0; s < 128; ++s) { run += sb[s]; sb[s] = run; const float ib = sib[s] - run; sib[s] = ib; mx = fmaxf(mx, ib); spm[s] = mx; }
  }
  if (tid == 64) {
    float run = 0.f, mx = -INFINITY;
    for (int s = 127; s >= 0; --s) { run += sb[128 + s]; sb[128 + s] = run; const float ib = sib[128 + s] - run; sib[128 + s] = ib; mx = fmaxf(mx, ib); spm[128 + s] = mx; }
  }
  __syncthreads();
}
DEV void mlstm_local_item(KP p, int l, int b, int h, int cpos, char* smem) {
  const int tid = otid(), lane = tid & 63, wid = tid >> 6, wm = wid >> 1, wn = wid & 1, fr = lane & 15, fq = lane >> 4;
  bf16_t* sKt = (bf16_t*)smem;
  bf16_t* sVt = sKt + 128 * ML_LD;
  float* sb = (float*)(sVt + 128 * ML_LD);
  float* sib = sb + 256; float* spm = sib + 256; float* sgl = spm + 256;
  const bf16_t* ML = (const bf16_t*)(p->ws + OFF_ML);
  float* STATES = (float*)(p->ws + OFF_STATES); float* STATS = (float*)(p->ws + OFF_STATS);
  const int row0 = chunk_row0(b, cpos);
  __syncthreads();
  mlstm_prep(p, l, row0, h, sb, sib, spm);
#pragma unroll 2
  for (int i = 0; i < 8; ++i) {
    const int id = tid + 256 * i, s = id >> 4, kc = id & 15;
    uint4 v = *(const uint4*)(ML + (size_t)(row0 + s) * 2048 + 512 + h * 128 + kc * 8);
    const bf16_t* e = (const bf16_t*)&v;
#pragma unroll
    for (int q = 0; q < 8; ++q) sKt[(kc * 8 + q) * ML_LD + s] = e[q];
  }
#pragma unroll 1
  for (int dir = 0; dir < 2; ++dir) {
    const int chain = (b * 4 + h) * 2 + dir, sidx = scan_idx(cpos, dir);
    const float bl = dir == 0 ? sb[127] : sb[128], maxib = dir == 0 ? spm[127] : spm[128];
    __syncthreads();
    if (tid < 128) sgl[tid] = __expf(sib[dir * 128 + tid] - maxib);
    __syncthreads();
#pragma unroll 2
    for (int i = 0; i < 8; ++i) {
      const int id = tid + 256 * i, s = id >> 4, vc = id & 15;
      uint4 v = *(const uint4*)(ML + (size_t)(row0 + s) * 2048 + 1024 + h * 128 + vc * 8);
      const bf16_t* e = (const bf16_t*)&v; const float g = sgl[s];
#pragma unroll
      for (int q = 0; q < 8; ++q) sVt[(vc * 8 + q) * ML_LD + s] = f2bf(g * bf2f(e[q]));
    }
    __syncthreads();
    float* dst = STATES + ((size_t)chain * 34 + sidx) * 16512;
#pragma unroll
    for (int mi = 0; mi < 4; ++mi) {
      f32x4 acc[4];
#pragma unroll
      for (int ni = 0; ni < 4; ++ni) acc[ni] = (f32x4){0.f, 0.f, 0.f, 0.f};
      wave_mma<4, 4>(sVt + (wm * 64 + mi * 16 + fr) * ML_LD + fq * 8, sKt + (wn * 64 + fr) * ML_LD + fq * 8, ML_LD, acc);
#pragma unroll
      for (int ni = 0; ni < 4; ++ni) *(f32x4*)(dst + (wm * 64 + mi * 16 + fr) * 128 + wn * 64 + ni * 16 + fq * 4) = acc[ni] * ML_SCALE;
    }
    if (tid < 128) {
      float a = 0.f;
      for (int s = 0; s < 128; ++s) a += sgl[s] * bf2f(sKt[tid * ML_LD + s]);
      dst[16384 + tid] = a * ML_SCALE;
    }
    if (tid == 0) { STATS[(chain * 34 + sidx) * 4 + 0] = bl; STATS[(chain * 34 + sidx) * 4 + 1] = bl + maxib; }
  }
}
DEV void mlstm_scan_phase(KP p) {
  float* STATES = (float*)(p->ws + OFF_STATES); float* STATS = (float*)(p->ws + OFF_STATS);
  const int gtid = blockIdx.x * NTH + otid(), gsz = gridDim.x * NTH;
  for (int i = gtid; i < 32 * 16512; i += gsz) {
    const int chain = i / 16512, e = i % 16512;
    float* base = STATES + (size_t)chain * 34 * 16512 + e;
    const float* st = STATS + chain * 34 * 4;
    float m = 0.f, S = 0.f;
#pragma unroll 1
    for (int half = 0; half < 2; ++half) {
      float lc[17];
#pragma unroll
      for (int k = 0; k < 17; ++k) lc[k] = base[(size_t)(half * 17 + k) * 16512];
#pragma unroll
      for (int k = 0; k < 17; ++k) {
        const int sidx = half * 17 + k;
        const float bl = st[sidx * 4 + 0], ms = st[sidx * 4 + 1];
        base[(size_t)sidx * 16512] = S;
        if (e == 0) STATS[(chain * 34 + sidx) * 4 + 2] = m;
        const float mn = fmaxf(bl + m, ms);
        S = __expf(bl + m - mn) * S + __expf(ms - mn) * lc[k];
        m = mn;
      }
    }
  }
}
DEV void mlstm_out_item(KP p, int l, int b, int h, int cpos, int half, char* smem) {
  const int tid = otid(), lane = tid & 63, w = tid >> 6, fr = lane & 15, fq = lane >> 4;
  bf16_t* sQ = (bf16_t*)smem;
  bf16_t* sP = sQ + 64 * ML_LD;
  bf16_t* sR = sP + 64 * ML_LD;
  float* sb = (float*)(sR + 128 * ML_LD); float* sib = sb + 256; float* spm = sib + 256; float* sn = spm + 256;
  const bf16_t* ML = (const bf16_t*)(p->ws + OFF_ML);
  const float* STATES = (const float*)(p->ws + OFF_STATES); const float* STATS = (const float*)(p->ws + OFF_STATS);
  bf16_t* MLS = (bf16_t*)(p->ws + OFF_MLS);
  const int row0 = chunk_row0(b, cpos);
  __syncthreads();
  mlstm_prep(p, l, row0, h, sb, sib, spm);
#pragma unroll
  for (int i = 0; i < 4; ++i) {
    const int id = tid + 256 * i, r = id >> 4, kc = id & 15;
    *(uint4*)(sQ + r * ML_LD + kc * 8) = *(const uint4*)(ML + (size_t)(row0 + half * 64 + r) * 2048 + h * 128 + kc * 8);
  }
  f32x4 hs[8];
#pragma unroll
  for (int ni = 0; ni < 8; ++ni) hs[ni] = (f32x4){0.f, 0.f, 0.f, 0.f};
  const int tl = half * 64 + w * 16 + fr;
#pragma unroll 1
  for (int dir = 0; dir < 2; ++dir) {
    const int chain = (b * 4 + h) * 2 + dir, sidx = scan_idx(cpos, dir);
    const float m_in = STATS[(chain * 34 + sidx) * 4 + 2];
    __syncthreads();
#pragma unroll 2
    for (int i = 0; i < 8; ++i) {
      const int id = tid + 256 * i, r = id >> 4, kc = id & 15;
      *(uint4*)(sR + r * ML_LD + kc * 8) = *(const uint4*)(ML + (size_t)(row0 + r) * 2048 + 512 + h * 128 + kc * 8);
    }
    __syncthreads();
    f32x4 acc[8];
#pragma unroll
    for (int ni = 0; ni < 8; ++ni) acc[ni] = (f32x4){0.f, 0.f, 0.f, 0.f};
    wave_mma<8, 4>(sQ + (w * 16 + fr) * ML_LD + fq * 8, sR + fr * ML_LD + fq * 8, ML_LD, acc);
    const float bt = sb[dir * 128 + tl], pmx = spm[dir * 128 + tl];
    const float mt = fmaxf(bt + m_in, bt + pmx);
    float rs = 0.f;
#pragma unroll
    for (int ni = 0; ni < 8; ++ni) {
      float pv[4];
#pragma unroll
      for (int j = 0; j < 4; ++j) {
        const int s = ni * 16 + fq * 4 + j;
        const bool valid = dir == 0 ? (s <= tl) : (s >= tl);
        const float e = valid ? __expf(bt + sib[dir * 128 + s] - mt) : 0.f;
        pv[j] = acc[ni][j] * ML_SCALE * e; rs += pv[j];
      }
      uint2 pk; pk.x = pack2(pv[0], pv[1]); pk.y = pack2(pv[2], pv[3]);
      *(uint2*)(sP + (w * 16 + fr) * ML_LD + ni * 16 + fq * 4) = pk;
    }
    rs = quad_sum(rs);
    __syncthreads();
    const float* Cs = STATES + ((size_t)chain * 34 + sidx) * 16512;
#pragma unroll 2
    for (int i = 0; i < 16; ++i) {
      const int id = tid + 256 * i, r = id >> 5, kc = id & 31;
      const float4 v = *(const float4*)(Cs + r * 128 + kc * 4);
      uint2 pk; pk.x = pack2(v.x, v.y); pk.y = pack2(v.z, v.w);
      *(uint2*)(sR + r * ML_LD + kc * 4) = pk;
    }
    if (tid < 128) sn[tid] = Cs[16384 + tid];
    __syncthreads();
#pragma unroll
    for (int ni = 0; ni < 8; ++ni) acc[ni] = (f32x4){0.f, 0.f, 0.f, 0.f};
    wave_mma<8, 4>(sQ + (w * 16 + fr) * ML_LD + fq * 8, sR + fr * ML_LD + fq * 8, ML_LD, acc);
    float qn = 0.f;
#pragma unroll 8
    for (int k = 0; k < 32; ++k) qn += bf2f(sQ[(w * 16 + fr) * ML_LD + fq * 32 + k]) * sn[fq * 32 + k];
    qn = quad_sum(qn);
    const float wi = __expf(bt + m_in - mt);
#pragma unroll
    for (int ni = 0; ni < 8; ++ni) acc[ni] *= wi;
    __syncthreads();
#pragma unroll 2
    for (int i = 0; i < 8; ++i) {
      const int id = tid + 256 * i, s = id >> 4, vc = id & 15;
      uint4 v = *(const uint4*)(ML + (size_t)(row0 + s) * 2048 + 1024 + h * 128 + vc * 8);
      const bf16_t* e = (const bf16_t*)&v;
#pragma unroll
      for (int q = 0; q < 8; ++q) sR[(vc * 8 + q) * ML_LD + s] = e[q];
    }
    __syncthreads();
    wave_mma<8, 4>(sP + (w * 16 + fr) * ML_LD + fq * 8, sR + fr * ML_LD + fq * 8, ML_LD, acc);
    const float den = wi * qn + rs;
    const float idd = 1.f / fmaxf(fabsf(den), __expf(-mt));
#pragma unroll
    for (int ni = 0; ni < 8; ++ni) hs[ni] += acc[ni] * idd;
  }
  float ss = 0.f;
#pragma unroll
  for (int ni = 0; ni < 8; ++ni) ss += hs[ni][0] * hs[ni][0] + hs[ni][1] * hs[ni][1] + hs[ni][2] * hs[ni][2] + hs[ni][3] * hs[ni][3];
  ss = quad_sum(ss);
  const float inv = rsqrtf(ss * (1.f / 128.f) + EPS);
  const size_t row = (size_t)(row0 + tl);
#pragma unroll
  for (int ni = 0; ni < 8; ++ni) {
    const int v0 = ni * 16 + fq * 4;
    const float4 g = *(const float4*)(p->ml_norm_g + (size_t)l * 512 + h * 128 + v0);
    const uint2 ob = *(const uint2*)(ML + row * 2048 + 1536 + h * 128 + v0);
    const float o0 = bf2f((bf16_t)(ob.x & 0xffff)), o1 = bf2f((bf16_t)(ob.x >> 16)), o2 = bf2f((bf16_t)(ob.y & 0xffff)), o3 = bf2f((bf16_t)(ob.y >> 16));
    uint2 pk;
    pk.x = pack2(hs[ni][0] * inv * g.x * sigm(o0), hs[ni][1] * inv * g.y * sigm(o1));
    pk.y = pack2(hs[ni][2] * inv * g.z * sigm(o2), hs[ni][3] * inv * g.w * sigm(o3));
    *(uint2*)(MLS + row * 512 + h * 128 + v0) = pk;
  }
}

__global__ void __launch_bounds__(NTH, 2) fwd_megakernel(Params p_unused) {
  cg::grid_group grid = cg::this_grid();
  __shared__ __attribute__((aligned(16))) char smem[SMEM_BYTES];
  const int nblk = gridDim.x, bid = blockIdx.x;
  KP kp = (KP)__builtin_amdgcn_kernarg_segment_ptr();

  phase0(lp(kp), smem);
  grid.sync();

#pragma unroll 1
  for (int l = 0; l < 4; ++l) {
    const int tid = otid();
    char* ws = lp(kp)->ws;
    float* X = (float*)(ws + OFF_X);
    bf16_t* A = (bf16_t*)(ws + OFF_A);
    const bool need_ctx = l < 3;
    const int mtiles = need_ctx ? 136 : 128;
    const float* MOD = (const float*)(ws + OFF_MOD) + (size_t)l * 5 * 6144;
    cvt_job(lp(kp)->w_in + (size_t)l * 1024 * N_IN, N_IN, 1024, N_INP, (bf16_t*)(ws + OFF_WIN), 1, smem);
    cvt_job(lp(kp)->w_in + (size_t)l * 1024 * N_IN, N_IN, 1024, 3072, (bf16_t*)(ws + OFF_WG), 2, smem);
    for (int r = 0; r < 3; ++r)
      cvt_job(lp(kp)->w_branch + ((size_t)l * 3 + r) * 512 * 1024, 1024, 512, 1024, (bf16_t*)(ws + OFF_WBR) + (size_t)r * 1024 * 512, 0, smem);
    cvt_job(lp(kp)->w_out + (size_t)l * 1024 * 1024, 1024, 1024, 1024, (bf16_t*)(ws + OFF_WOUT), 0, smem);
    cvt_job(lp(kp)->w_up + (size_t)l * 1024 * 5632, 5632, 1024, 5632, (bf16_t*)(ws + OFF_WUP), 0, smem);
    cvt_job(lp(kp)->w_down + (size_t)l * 2816 * 1024, 1024, 2816, 1024, (bf16_t*)(ws + OFF_WDN), 0, smem);
    for (int it = bid; it < 1024; it += nblk) {
#ifndef NO_FILT
      if (it < 512) filt_item<16>(lp(kp), l, it, false, smem);
      else filt_item<1>(lp(kp), l, it - 512, true, smem);
#endif
    }
    norm_mod_phase(lp(kp), l, lp(kp)->norm1_g + (size_t)l * D, 0, 1024, M_ALL);
    grid.sync();
    {
      const bf16_t* Wt = (const bf16_t*)(ws + OFF_WIN);
      bf16_t* QKV = (bf16_t*)(ws + OFF_QKV); bf16_t* ML = (bf16_t*)(ws + OFF_ML); float* MLG = (float*)(ws + OFF_MLG);
      bf16_t* HYT = (bf16_t*)(ws + OFF_HYT); bf16_t* HYTC = (bf16_t*)(ws + OFF_HYTC);
      for (int tile = bid; tile < 136 * 35; tile += nblk) {
        const int mt = tile / 35, nt = tile % 35, m0 = mt * 128, n0 = nt * 128;
        f32x4 acc[4][4]; zero_acc<4>(acc);
        gemm_mainloop<4>(A, D, Wt, D, D, m0, n0, acc, smem);
        if (nt < 6) gemm_epi<4>(acc, m0, n0, [&](int m, int n, f32x4 v) {
          uint2 pk; pk.x = pack2(v[0], v[1]); pk.y = pack2(v[2], v[3]); *(uint2*)(QKV + (size_t)m * 768 + n) = pk; });
        else if (nt < 22) gemm_epi<4>(acc, m0, n0, [&](int m, int n, f32x4 v) {
          uint2 pk; pk.x = pack2(v[0], v[1]); pk.y = pack2(v[2], v[3]); *(uint2*)(ML + (size_t)m * 2048 + (n - 768)) = pk; });
        else if (nt < 34) gemm_epi<4>(acc, m0, n0, [&](int m, int n, f32x4 v) {
          const int hc = n - 2816;
          if (m < M_LAT) { const int b = m >> 12, t = m & 4095;
#pragma unroll
            for (int j = 0; j < 4; ++j) HYT[((size_t)b * 1536 + hc + j) * L + t] = f2bf(v[j]); }
          else { const int mc = m - M_LAT, b = mc >> 8, t = mc & 255;
#pragma unroll
            for (int j = 0; j < 4; ++j) HYTC[((size_t)b * 1536 + hc + j) * LC + t] = f2bf(v[j]); } });
        else gemm_epi<4>(acc, m0, n0, [&](int m, int n, f32x4 v) { const int gc = n - 4352; if (gc < 16) *(f32x4*)(MLG + (size_t)m * 16 + gc) = v; });
      }
    }
    grid.sync();
    {
      const int n_hl = 1024, n_al = 1024, n_ml = 544, n_hc = need_ctx ? 1024 : 0, n_ac = need_ctx ? 64 : 0;
      const int total = n_hl + n_al + n_ml + n_hc + n_ac;
      for (int it = bid; it < total; it += nblk) {
        int i = it;
#ifndef NO_HY
        if (i < n_hl) { hyena_item<13>(lp(kp), l, i >> 1, i & 1, false, smem); continue; }
#endif
        i -= n_hl;
#ifndef NO_ATT
        if (i < n_al) { attn_item(lp(kp), l, i >> 8, (i >> 3) & 31, i & 7, false, smem); continue; }
#endif
        i -= n_al;
#ifndef NO_MLL
        if (i < n_ml) { mlstm_local_item(lp(kp), l, i / 136, (i / 34) & 3, i % 34, smem); continue; }
#endif
        i -= n_ml;
#ifndef NO_HYC
        if (i < n_hc) { hyena_item<9>(lp(kp), l, i >> 1, i & 1, true, smem); continue; }
#endif
        i -= n_hc;
#ifndef NO_ATT
        attn_item(lp(kp), l, i >> 4, (i >> 3) & 1, i & 7, true, smem);
#endif
      }
    }
    grid.sync();
#ifndef NO_SCAN
    mlstm_scan_phase(lp(kp));
#endif
    grid.sync();
    {
      const int c0 = need_ctx ? 0 : 2, ncp = 34 - c0;
      for (int it = bid; it < 16 * ncp * 2; it += nblk) {
        const int half = it & 1, r = it >> 1, cpos = c0 + r % ncp, bh = r / ncp;
#ifndef NO_MLO
        mlstm_out_item(lp(kp), l, bh >> 2, bh & 3, cpos, half, smem);
#endif
      }
    }
    grid.sync();
    {
      bf16_t* Y = (bf16_t*)(ws + OFF_Y);
      const bf16_t* Wg = (const bf16_t*)(ws + OFF_WG); const bf16_t* Wb = (const bf16_t*)(ws + OFF_WBR);
      for (int tile = bid; tile < mtiles * 16; tile += nblk) {
        const int m0 = (tile >> 4) * 128, n0 = (tile & 15) * 64;
        f32x4 y[4][2]; zero_acc<2>(y);
#pragma unroll 1
        for (int r = 0; r < 3; ++r) {
          const bf16_t* Br = (const bf16_t*)(ws + (r == 0 ? OFF_ATT : (r == 1 ? OFF_MLS : OFF_HYO)));
          f32x4 ag[4][2], ab[4][2]; zero_acc<2>(ag); zero_acc<2>(ab);
          gemm_mainloop<2>(A, D, Wg + (size_t)r * 1024 * 1024, D, D, m0, n0, ag, smem);
          gemm_mainloop<2>(Br, 512, Wb + (size_t)r * 1024 * 512, 512, 512, m0, n0, ab, smem);
#pragma unroll
          for (int mi = 0; mi < 4; ++mi)
#pragma unroll
            for (int ni = 0; ni < 2; ++ni)
#pragma unroll
              for (int j = 0; j < 4; ++j) y[mi][ni][j] += sigm(ag[mi][ni][j]) * ab[mi][ni][j];
        }
        gemm_epi<2>(y, m0, n0, [&](int m, int n, f32x4 v) {
          uint2 pk; pk.x = pack2(v[0], v[1]); pk.y = pack2(v[2], v[3]); *(uint2*)(Y + (size_t)m * D + n) = pk; });
      }
    }
    grid.sync();
    {
      const bf16_t* Y = (const bf16_t*)(ws + OFF_Y); const bf16_t* Wt = (const bf16_t*)(ws + OFF_WOUT);
      for (int tile = bid; tile < mtiles * 16; tile += nblk) {
        const int m0 = (tile >> 4) * 128, n0 = (tile & 15) * 64;
        f32x4 acc[4][2]; zero_acc<2>(acc);
        gemm_mainloop<2>(Y, D, Wt, D, D, m0, n0, acc, smem);
        gemm_epi<2>(acc, m0, n0, [&](int m, int n, f32x4 v) {
          const f32x4 g = *(const f32x4*)(MOD + (size_t)row_bi(m) * 6144 + 2048 + n);
          f32x4* xp = (f32x4*)(X + (size_t)m * D + n); *xp = *xp + g * v; });
      }
    }
    grid.sync();
    norm_mod_phase(lp(kp), l, lp(kp)->norm2_g + (size_t)l * D, 3072, 4096, mtiles * 128);
    grid.sync();
    {
      bf16_t* U = (bf16_t*)(ws + OFF_U); const bf16_t* Wt = (const bf16_t*)(ws + OFF_WUP);
      for (int tile = bid; tile < mtiles * 44; tile += nblk) {
        const int m0 = (tile / 44) * 128, n0 = (tile % 44) * 128;
        f32x4 acc[4][4]; zero_acc<4>(acc);
        gemm_mainloop<4>(A, D, Wt, D, D, m0, n0, acc, smem);
        gemm_epi<4>(acc, m0, n0, [&](int m, int n, f32x4 v) {
          uint2 pk; pk.x = pack2(v[0], v[1]); pk.y = pack2(v[2], v[3]); *(uint2*)(U + (size_t)m * 5632 + n) = pk; });
      }
    }
    grid.sync();
    {
      const bf16_t* U = (const bf16_t*)(ws + OFF_U); bf16_t* G = (bf16_t*)(ws + OFF_G);
      const float* cw = lp(kp)->ffn_conv_w + (size_t)l * 3 * 5632; const float* cb = lp(kp)->ffn_conv_b + (size_t)l * 5632;
      const int total = mtiles * 128 * 352;
      for (int i = bid * NTH + tid; i < total; i += nblk * NTH) {
        const int m = i / 352, c8 = (i % 352) * 8;
        const int t = m < M_LAT ? (m & 4095) : ((m - M_LAT) & 255), Lx = m < M_LAT ? L : LC;
        const bool hm = t > 0, hp = t < Lx - 1;
        float gv[2][8];
#pragma unroll
        for (int part = 0; part < 2; ++part) {
          const int c = c8 + part * DFF;
          const uint4 z4 = make_uint4(0, 0, 0, 0);
          const uint4 u0 = *(const uint4*)(U + (size_t)m * 5632 + c);
          const uint4 um = hm ? *(const uint4*)(U + (size_t)(m - 1) * 5632 + c) : z4;
          const uint4 up = hp ? *(const uint4*)(U + (size_t)(m + 1) * 5632 + c) : z4;
          const bf16_t* e0 = (const bf16_t*)&u0; const bf16_t* em = (const bf16_t*)&um; const bf16_t* ep = (const bf16_t*)&up;
#pragma unroll
          for (int e = 0; e < 8; ++e)
            gv[part][e] = cb[c + e] + cw[c + e] * bf2f(em[e]) + cw[5632 + c + e] * bf2f(e0[e]) + cw[2 * 5632 + c + e] * bf2f(ep[e]);
        }
        uint4 o;
        o.x = pack2(gv[0][0] * sigm(gv[0][0]) * gv[1][0], gv[0][1] * sigm(gv[0][1]) * gv[1][1]);
        o.y = pack2(gv[0][2] * sigm(gv[0][2]) * gv[1][2], gv[0][3] * sigm(gv[0][3]) * gv[1][3]);
        o.z = pack2(gv[0][4] * sigm(gv[0][4]) * gv[1][4], gv[0][5] * sigm(gv[0][5]) * gv[1][5]);
        o.w = pack2(gv[0][6] * sigm(gv[0][6]) * gv[1][6], gv[0][7] * sigm(gv[0][7]) * gv[1][7]);
        *(uint4*)(G + (size_t)m * DFF + c8) = o;
      }
    }
    grid.sync();
    {
      const bf16_t* G = (const bf16_t*)(ws + OFF_G); const bf16_t* Wt = (const bf16_t*)(ws + OFF_WDN);
      for (int tile = bid; tile < mtiles * 16; tile += nblk) {
        const int m0 = (tile >> 4) * 128, n0 = (tile & 15) * 64;
        f32x4 acc[4][2]; zero_acc<2>(acc);
        gemm_mainloop<2>(G, DFF, Wt, DFF, DFF, m0, n0, acc, smem);
        gemm_epi<2>(acc, m0, n0, [&](int m, int n, f32x4 v) {
          const f32x4 g = *(const f32x4*)(MOD + (size_t)row_bi(m) * 6144 + 5120 + n);
          f32x4* xp = (f32x4*)(X + (size_t)m * D + n); *xp = *xp + g * v; });
      }
    }
    grid.sync();
  }
  {
    const int tid = otid();
    const float* X = (const float*)(lp(kp)->ws + OFF_X);
    const int lane = tid & 63, gw = bid * 4 + (tid >> 6), nw = nblk * 4;
    for (int m = gw; m < M_LAT; m += nw) {
      const float4* xr = (const float4*)(X + (size_t)m * D);
      float4 v[4]; float ss = 0.f;
#pragma unroll
      for (int i = 0; i < 4; ++i) { v[i] = xr[lane + 64 * i]; ss += v[i].x * v[i].x + v[i].y * v[i].y + v[i].z * v[i].z + v[i].w * v[i].w; }
      ss = wave_sum(ss);
      const float inv = rsqrtf(ss * (1.f / D) + EPS);
#pragma unroll
      for (int i = 0; i < 4; ++i) {
        const float4 g = ((const float4*)lp(kp)->final_g)[lane + 64 * i];
        ((float4*)(lp(kp)->out + (size_t)m * D))[lane + 64 * i] = make_float4(v[i].x * inv * g.x, v[i].y * inv * g.y, v[i].z * inv * g.z, v[i].w * inv * g.w);
      }
    }
  }
}

extern "C" void kernel_launch(void* const* d_in, const int* in_sizes, int n_in, void* d_out, int out_size, void* d_ws, size_t ws_size,
                              hipStream_t stream) {
  static int grid_blocks = 0;
  if (!grid_blocks) {
    int dev = 0, cus = 0, per_cu = 0;
    hipGetDevice(&dev);
    hipDeviceGetAttribute(&cus, hipDeviceAttributeMultiprocessorCount, dev);
    hipOccupancyMaxActiveBlocksPerMultiprocessor(&per_cu, fwd_megakernel, NTH, 0);
    if (per_cu > 2) per_cu = 2;
    grid_blocks = cus * per_cu;
  }
  if (ws_size < WS_NEED) { fprintf(stderr, "workspace too small: %zu < %zu\n", ws_size, (size_t)WS_NEED); return; }
  Params p{};
  const float** pp = (const float**)&p;
  for (int i = 0; i < 28; ++i) pp[i] = (const float*)d_in[i];
  p.out = (float*)d_out;
  p.ws = (char*)d_ws;
  void* args[] = {&p};
  hipError_t e = hipLaunchCooperativeKernel((void*)fwd_megakernel, dim3(grid_blocks), dim3(NTH), args, 0, stream);
  if (e != hipSuccess) fprintf(stderr, "cooperative launch failed: %s (grid %d)\n", hipGetErrorString(e), grid_blocks);
}
```
